# Optimizing an MI355X kernel written in HIP

```python
import jax, jax.numpy as jnp
from jax import lax
import numpy as np

D_MODEL = 1024
BATCH = 8
SEQ = 8192
DEPTH = 2

GRID_W = 64
CTX_LEN = 256
N_EVEN = (DEPTH + 1) // 2
N_ODD = DEPTH // 2
POOL_GROUPS = 4
POOL_WINDOWS = (2, 4, 8, 16)
POOL_DIM = D_MODEL // 2
POOL_GDIM = POOL_DIM // POOL_GROUPS
HEAD_DIM = 64
N_Q_HEADS = (D_MODEL // 2) // HEAD_DIM
N_KV_HEADS = 2
GQA_GROUP = N_Q_HEADS // N_KV_HEADS
Q_DIM = N_Q_HEADS * HEAD_DIM
KV_DIM = N_KV_HEADS * HEAD_DIM
WINDOW = 128
BLOCK = 128
ROPE_BASE = 10000.0
ROPE_HALF = HEAD_DIM // 2
IN_DIM = POOL_DIM + Q_DIM + 2 * KV_DIM
MIX_DIM = POOL_DIM + Q_DIM
FOURIER_GROUPS = 4
FOURIER_GDIM = D_MODEL // FOURIER_GROUPS
D_FF = 2816
N_MOD = 9
ALPHA = (2 * DEPTH) ** 0.25
BETA = (8 * DEPTH) ** -0.25
LN_EPS = 1e-5

kernel_name = "hybrid_pool_swa_fourier_macaron_dit"


def layer_norm(x, g=None, b=None):
    x32 = x.astype(jnp.float32)
    mu = jnp.mean(x32, axis=-1, keepdims=True)
    var = jnp.mean(jnp.square(x32 - mu), axis=-1, keepdims=True)
    y = (x32 - mu) * lax.rsqrt(var + LN_EPS)
    if g is not None:
        y = y * g.astype(jnp.float32) + b.astype(jnp.float32)
    return y.astype(x.dtype)


def modulate(x, shift, scale):
    return layer_norm(x) * (1 + scale) + shift


def swiglu(h, w1, w3, w2):
    return (jax.nn.silu(h @ w1) * (h @ w3)) @ w2


def rotate(t, ang):
    cos = jnp.cos(ang)[:, None, :].astype(t.dtype)
    sin = jnp.sin(ang)[:, None, :].astype(t.dtype)
    t1, t2 = jnp.split(t, 2, axis=-1)
    return jnp.concatenate([t1 * cos - t2 * sin, t1 * sin + t2 * cos], axis=-1)


def rope_2d(t, ang_row, ang_col):
    return jnp.concatenate([rotate(t[..., :ROPE_HALF], ang_row), rotate(t[..., ROPE_HALF:], ang_col)], axis=-1)


def pool_mixer(p, w_pool, pool_scale):
    b_, L, _ = p.shape
    p32 = p.astype(jnp.float32).reshape(b_, L, POOL_GROUPS, POOL_GDIM)
    csum = jnp.concatenate([jnp.zeros_like(p32[:, :1]), jnp.cumsum(p32, axis=1)], axis=1)
    t = jnp.arange(L)
    outs = []
    for g, w in enumerate(POOL_WINDOWS):
        lo = jnp.clip(t - w // 2, 0, L)
        hi = jnp.clip(t + w // 2, 0, L)
        cs = csum[:, :, g]
        win_sum = jnp.take(cs, hi, axis=1) - jnp.take(cs, lo, axis=1)
        mean = win_sum / (hi - lo).astype(jnp.float32)[None, :, None]
        outs.append((mean - p32[:, :, g]).astype(p.dtype) @ w_pool[g])
    return jnp.concatenate(outs, axis=-1) * pool_scale


def banded_gqa(q, k, v, k_ctx, v_ctx, sinks):
    b_, L = q.shape[:2]
    nb = L // BLOCK
    scale = HEAD_DIM ** -0.5
    qb = q.reshape(b_, nb, BLOCK, N_KV_HEADS, GQA_GROUP, HEAD_DIM)

    def band(t):
        tp = jnp.pad(t, ((0, 0), (BLOCK, BLOCK), (0, 0), (0, 0))).reshape(b_, nb + 2, BLOCK, N_KV_HEADS, HEAD_DIM)
        return jnp.concatenate([tp[:, :-2], tp[:, 1:-1], tp[:, 2:]], axis=2)

    kb, vb = band(k), band(v)
    s_loc = jnp.einsum('bnqhgd,bnkhd->bnhgqk', qb, kb).astype(jnp.float32) * scale
    s_ctx = jnp.einsum('bnqhgd,bchd->bnhgqc', qb, k_ctx).astype(jnp.float32) * scale
    qi = jnp.arange(BLOCK)[:, None]
    ki = jnp.arange(3 * BLOCK)[None, :]
    key_pos = jnp.arange(nb)[:, None, None] * BLOCK - BLOCK + ki[None]
    valid = (jnp.abs(ki - BLOCK - qi) <= WINDOW)[None] & (key_pos >= 0) & (key_pos < L)
    s_loc = jnp.where(valid[None, :, None, None], s_loc, -jnp.inf)
    sink = sinks.astype(jnp.float32).reshape(1, 1, N_KV_HEADS, GQA_GROUP, 1, 1)
    m = jnp.maximum(jnp.maximum(jnp.max(s_loc, axis=-1, keepdims=True), jnp.max(s_ctx, axis=-1, keepdims=True)), sink)
    e_loc = jnp.exp(s_loc - m)
    e_ctx = jnp.exp(s_ctx - m)
    denom = jnp.sum(e_loc, axis=-1, keepdims=True) + jnp.sum(e_ctx, axis=-1, keepdims=True) + jnp.exp(sink - m)
    out = (jnp.einsum('bnhgqk,bnkhd->bnhgqd', e_loc, vb.astype(jnp.float32))
           + jnp.einsum('bnhgqc,bchd->bnhgqd', e_ctx, v_ctx.astype(jnp.float32))) / denom
    out = jnp.transpose(out, (0, 1, 4, 2, 3, 5)).astype(q.dtype)
    return out.reshape(b_, L, Q_DIM)


def mixer_pool_attn(h, h_ctx, w_in, w_pool, pool_scale, sinks, w_out, ang_row, ang_col):
    b_, L, _ = h.shape
    u = h @ w_in
    p, q, k, v = jnp.split(u, [POOL_DIM, POOL_DIM + Q_DIM, POOL_DIM + Q_DIM + KV_DIM], axis=-1)
    kv_ctx = h_ctx @ w_in[:, POOL_DIM + Q_DIM:]
    k_ctx, v_ctx = jnp.split(kv_ctx, 2, axis=-1)
    n_ctx = h_ctx.shape[1]
    q = rope_2d(q.reshape(b_, L, N_Q_HEADS, HEAD_DIM), ang_row, ang_col)
    k = rope_2d(k.reshape(b_, L, N_KV_HEADS, HEAD_DIM), ang_row, ang_col)
    v = v.reshape(b_, L, N_KV_HEADS, HEAD_DIM)
    k_ctx = k_ctx.reshape(b_, n_ctx, N_KV_HEADS, HEAD_DIM)
    v_ctx = v_ctx.reshape(b_, n_ctx, N_KV_HEADS, HEAD_DIM)
    a = pool_mixer(p, w_pool, pool_scale)
    o = banded_gqa(q, k, v, k_ctx, v_ctx, sinks)
    return jnp.concatenate([a, o], axis=-1) @ w_out


def fourier_mixer(h, w_out):
    b_, L, _ = h.shape
    hg = h.astype(jnp.float32).reshape(b_, L, FOURIER_GROUPS, FOURIER_GDIM)
    f = jnp.fft.fft2(hg, axes=(1, 3), norm='ortho').real
    return f.reshape(b_, L, D_MODEL).astype(h.dtype) @ w_out


def setup_inputs(seed: int = 0) -> dict:
    key = jax.random.key(seed)
    ks = jax.random.split(key, 20)

    def nrm(k, shape, s):
        return jax.random.normal(k, shape, jnp.float32) * s

    return {
        'x': nrm(ks[0], (BATCH, SEQ, D_MODEL), 1.0),
        'c': nrm(ks[1], (BATCH, D_MODEL), 1.0),
        'ctx': nrm(ks[2], (BATCH, CTX_LEN, D_MODEL), 1.0),
        'c_ctx': nrm(ks[3], (D_MODEL,), 1.0),
        'ada_w': nrm(ks[4], (DEPTH, D_MODEL, N_MOD * D_MODEL), 0.5 * D_MODEL ** -0.5),
        'ada_b': nrm(ks[5], (DEPTH, N_MOD * D_MODEL), 0.02),
        'ln_g': 1.0 + nrm(ks[6], (DEPTH, 3, D_MODEL), 0.02),
        'ln_b': nrm(ks[7], (DEPTH, 3, D_MODEL), 0.02),
        'ffn1_w1': nrm(ks[8], (DEPTH, D_MODEL, D_FF), D_MODEL ** -0.5),
        'ffn1_w3': nrm(ks[9], (DEPTH, D_MODEL, D_FF), D_MODEL ** -0.5),
        'ffn1_w2': nrm(ks[10], (DEPTH, D_FF, D_MODEL), BETA * D_FF ** -0.5),
        'ffn2_w1': nrm(ks[11], (DEPTH, D_MODEL, D_FF), D_MODEL ** -0.5),
        'ffn2_w3': nrm(ks[12], (DEPTH, D_MODEL, D_FF), D_MODEL ** -0.5),
        'ffn2_w2': nrm(ks[13], (DEPTH, D_FF, D_MODEL), BETA * D_FF ** -0.5),
        'mix_w_in': nrm(ks[14], (N_EVEN, D_MODEL, IN_DIM), D_MODEL ** -0.5),
        'pool_w': nrm(ks[15], (N_EVEN, POOL_GROUPS, POOL_GDIM, POOL_GDIM), POOL_GDIM ** -0.5),
        'pool_scale': 1.0 + nrm(ks[16], (N_EVEN, POOL_DIM), 0.02),
        'attn_sinks': nrm(ks[17], (N_EVEN, N_Q_HEADS), 0.5),
        'mix_w_out': nrm(ks[18], (N_EVEN, MIX_DIM, D_MODEL), BETA * MIX_DIM ** -0.5),
        'fourier_w_out': nrm(ks[19], (N_ODD, D_MODEL, D_MODEL), BETA * D_MODEL ** -0.5),
    }


def reference(x, c, ctx, c_ctx, ada_w, ada_b, ln_g, ln_b, ffn1_w1, ffn1_w3, ffn1_w2, ffn2_w1, ffn2_w3, ffn2_w2,
              mix_w_in, pool_w, pool_scale, attn_sinks, mix_w_out, fourier_w_out):
    L = x.shape[1]
    ROWS = L // GRID_W
    row = jnp.repeat(jnp.arange(ROWS), GRID_W).astype(jnp.float32)
    col = jnp.tile(jnp.arange(GRID_W), ROWS).astype(jnp.float32)
    freqs = ROPE_BASE ** (-jnp.arange(0, ROPE_HALF, 2, dtype=jnp.float32) / ROPE_HALF)
    ang_row = row[:, None] * freqs[None]
    ang_col = col[:, None] * freqs[None]
    silu_c = jax.nn.silu(c)
    silu_cc = jax.nn.silu(c_ctx)
    for l in range(DEPTH):
        mod = (silu_c @ ada_w[l] + ada_b[l])[:, None, :]
        sh1, sc1, g1, sh2, sc2, g2, sh3, sc3, g3 = jnp.split(mod, N_MOD, axis=-1)
        y = swiglu(modulate(x, sh1, sc1), ffn1_w1[l], ffn1_w3[l], ffn1_w2[l])
        x = layer_norm(ALPHA * x + 0.5 * g1 * y, ln_g[l, 0], ln_b[l, 0])
        if l % 2 == 0:
            e = l // 2
            mod_c = (silu_cc @ ada_w[l][:, :5 * D_MODEL] + ada_b[l][:5 * D_MODEL])[None, None, :]
            csh1, csc1, cg1, csh2, csc2 = jnp.split(mod_c, 5, axis=-1)
            yc = swiglu(modulate(ctx, csh1, csc1), ffn1_w1[l], ffn1_w3[l], ffn1_w2[l])
            ctx = layer_norm(ALPHA * ctx + 0.5 * cg1 * yc, ln_g[l, 0], ln_b[l, 0])
            mix = mixer_pool_attn(modulate(x, sh2, sc2), modulate(ctx, csh2, csc2), mix_w_in[e], pool_w[e],
                                  pool_scale[e], attn_sinks[e], mix_w_out[e], ang_row, ang_col)
        else:
            mix = fourier_mixer(modulate(x, sh2, sc2), fourier_w_out[l // 2])
        x = layer_norm(ALPHA * x + g2 * mix, ln_g[l, 1], ln_b[l, 1])
        y = swiglu(modulate(x, sh3, sc3), ffn2_w1[l], ffn2_w3[l], ffn2_w2[l])
        x = layer_norm(ALPHA * x + 0.5 * g3 * y, ln_g[l, 2], ln_b[l, 2])
    return x
```

```cpp
#include <hip/hip_runtime.h>
#include <hip/hip_cooperative_groups.h>
#include <cstdio>
#include <cstdint>
namespace cg = cooperative_groups;

#ifndef CHK
#define CHK 0
#endif

#define LAS __attribute__((address_space(3)))
typedef unsigned short bf16_t;
typedef short bf16x8 __attribute__((ext_vector_type(8)));
typedef short s16x4 __attribute__((ext_vector_type(4)));
typedef float f32x4 __attribute__((ext_vector_type(4)));
typedef float f32x2 __attribute__((ext_vector_type(2)));
typedef unsigned u32x4 __attribute__((ext_vector_type(4)));
typedef unsigned u32x2 __attribute__((ext_vector_type(2)));

constexpr int D = 1024, NBATCH = 8, SEQ = 8192, MLAT = NBATCH * SEQ, NCTX = 256, MCTX = NBATCH * NCTX, MR = MLAT + MCTX;
constexpr int DFF = 2816, NUP = 2 * DFF, INDIM = 1280;
constexpr float ALPHA = 1.41421356237f, LN_EPS = 1e-5f, LOG2E = 1.44269504089f;
constexpr size_t MiB = 1u << 20;
constexpr size_t WS_CTL = 0, WS_MOD = 1 * MiB, WS_ROPE = 2 * MiB, WS_WCH = 2 * MiB + 65536, WS_WA = WS_WCH + 262144, WS_WC = WS_WA + 131072, WS_WPBD = 3 * MiB;
constexpr size_t WS_WUP = 4 * MiB, WUP_SZ = (size_t)NUP * D * 2, WS_WDN = 48 * MiB, WDN_SZ = (size_t)D * DFF * 2, WS_WIN = 70 * MiB, WS_WOUT = 73 * MiB, WS_WF = 75 * MiB;
constexpr size_t WS_Z = 88 * MiB, WS_HID = 352 * MiB, WS_H = 715 * MiB, WS_END = 1024 * MiB;
constexpr size_t WS_UIN = WS_HID, WS_PD = 517 * MiB, WS_AO = 581 * MiB;
constexpr size_t WS_YT = WS_HID, WS_UT = WS_H, WS_F = WS_HID;
static_assert(WS_WUP + 4 * WUP_SZ <= WS_WDN && WS_WDN + 4 * WDN_SZ <= WS_WIN && WS_Z + (size_t)MR * D * 4 <= WS_HID && WS_HID + (size_t)MR * DFF * 2 <= WS_H && WS_H + (size_t)MR * D * 2 <= WS_END, "ws map");
static_assert(WS_UIN + (size_t)MR * INDIM * 2 <= WS_PD && WS_PD + (size_t)MLAT * 512 * 2 <= WS_AO && WS_AO + (size_t)MLAT * D * 2 <= WS_H && WS_UT + (size_t)MLAT * 2048 * 2 <= WS_END, "ws overlays");

__device__ __forceinline__ unsigned f2bf(float f) { unsigned u = __builtin_bit_cast(unsigned, f); return (u + 0x7fffu + ((u >> 16) & 1u)) >> 16; }
__device__ __forceinline__ unsigned pk2(float lo, float hi) { return f2bf(lo) | (f2bf(hi) << 16); }
__device__ __forceinline__ float bf2f(unsigned v) { return __builtin_bit_cast(float, (v & 0xffffu) << 16); }
__device__ __forceinline__ unsigned cvt_pk_bf16(float lo, float hi) { unsigned r; asm volatile("v_cvt_pk_bf16_f32 %0, %1, %2" : "=v"(r) : "v"(lo), "v"(hi)); return r; }
__device__ __forceinline__ float silu_f(float a) { return a * __builtin_amdgcn_rcpf(1.0f + __builtin_amdgcn_exp2f(-a * LOG2E)); }
__device__ __forceinline__ float wave_sum(float v) {
#pragma unroll
    for (int o = 1; o < 64; o <<= 1) v += __shfl_xor(v, o);
    return v;
}

namespace pg8 {
constexpr int BM = 256, BK = 64, HALF = 128, HTB = HALF * BK * 2, STAGE_BYTES = 8 * HTB, NXCD = 8, WGM = 8;
__device__ __forceinline__ int lds_byte(int r, int c) { const int st = (r >> 4) * 2 + (c >> 5), rr = r & 15, cc = c & 31, ob = rr * 64 + cc * 2; return st * 1024 + (ob ^ (((ob >> 9) & 1) << 5)); }
__device__ __forceinline__ void stage_rc(int b, int& R, int& C) { const int st = b / 1024, sb = b % 1024, swz = sb ^ (((sb >> 9) & 1) << 5); R = (st >> 1) * 16 + swz / 64; C = (st & 1) * 32 + (swz % 64) / 2; }
__device__ __forceinline__ int perm32(int rho) { const int n = rho >> 4, i = rho & 15; return 8 * (i >> 2) + 4 * n + (i & 3); }

struct Unit { int pm, pn; size_t aoff, boff; };
struct Gemm { const bf16_t* A; const bf16_t* Bt; int K; unsigned a_row, b_row; size_t a_half, b_half; };

struct StdOrder {
    int nM, nN, nwg, G, c; size_t a_tile, b_tile;
    __device__ void init(int M, int N, int G_, int c_, size_t at, size_t bt) { nM = M / BM; nN = N / BM; nwg = nM * nN; G = G_; c = c_; a_tile = at; b_tile = bt; }
    __device__ bool next(int i, Unit& u) const {
        const long L = (long)i * G + c; if (L >= nwg) return false;
        int wgid = (int)L; { const int q = nwg / NXCD, r = nwg % NXCD, xcd = wgid % NXCD, off = wgid / NXCD; wgid = (xcd < r ? xcd * (q + 1) : r * (q + 1) + (xcd - r) * q) + off; }
        const int nig = WGM * nN, gid = wgid / nig, fm = gid * WGM, gsz = (nM - fm) < WGM ? (nM - fm) : WGM;
        u.pm = fm + ((wgid % nig) % gsz); u.pn = (wgid % nig) / gsz; u.aoff = (size_t)u.pm * a_tile; u.boff = (size_t)u.pn * b_tile; return true;
    }
};

template <class Epi, class Sched>
__device__ __forceinline__ void gemm_phase(LAS unsigned char* lds, const Gemm g, const Sched& S, const Epi& E) {
    int tid_ = threadIdx.x; asm volatile("" : "+v"(tid_));
    const int tid = tid_, wid = __builtin_amdgcn_readfirstlane(tid >> 6), lane = tid & 63, wr = wid >> 2, wc = wid & 3, fr = lane & 15, fq = lane >> 4;
    int K_ = g.K; asm volatile("" : "+s"(K_));
    const int K = K_, nt = K / BK;
    unsigned voffA[2], voffB[2];
#pragma unroll
    for (int i = 0; i < 2; ++i) { int R, C; stage_rc(tid * 16 + i * 8192, R, C); const int Rb = Epi::PERM ? ((R & ~31) + perm32(R & 31)) : R;
        voffA[i] = (unsigned)R * g.a_row + (unsigned)C * 2u; voffB[i] = (unsigned)Rb * g.b_row + (unsigned)C * 2u; }
    const size_t kstep = (size_t)(BK * 2);
    const size_t hA = g.a_half, hB = g.b_half;
    const unsigned ldsw = (unsigned)wid * 1024u;
    const int aoff = lds_byte(wr * 64 + fr, fq * 8), boff = lds_byte(wc * 32 + fr, fq * 8);
#define PG8_SA(b, h) (((b) * 2 + (h)) * HTB)
#define PG8_SB(b, h) ((4 + (b) * 2 + (h)) * HTB)
#define PG8_STAGE(bufoff, gbase, voff) do { _Pragma("unroll") for (int _i = 0; _i < 2; ++_i) \
        __builtin_amdgcn_global_load_lds((const unsigned*)((const char*)(gbase) + (voff)[_i]), (LAS unsigned*)(lds + (bufoff) + ldsw + _i * 8192), 16, 0, 0); } while (0)
#define PG8_LDA(dst, b, h) do { _Pragma("unroll") for (int m = 0; m < 4; ++m) _Pragma("unroll") for (int k = 0; k < 2; ++k) dst[m][k] = *(const LAS bf16x8*)(lds + PG8_SA(b, h) + aoff + m * 2048 + k * 1024); } while (0)
#define PG8_LDB(dst, b, h) do { _Pragma("unroll") for (int n = 0; n < 2; ++n) _Pragma("unroll") for (int k = 0; k < 2; ++k) dst[n][k] = *(const LAS bf16x8*)(lds + PG8_SB(b, h) + boff + n * 2048 + k * 1024); } while (0)
#define PG8_MMA(ai, bj, At, Bt) do { __builtin_amdgcn_s_setprio(1); _Pragma("unroll") for (int m = 0; m < 4; ++m) _Pragma("unroll") for (int n = 0; n < 2; ++n) _Pragma("unroll") for (int k = 0; k < 2; ++k) \
        acc[ai][bj][m][n] = __builtin_amdgcn_mfma_f32_16x16x32_bf16(Bt[n][k], At[m][k], acc[ai][bj][m][n], 0, 0, 0); __builtin_amdgcn_s_setprio(0); } while (0)
#define PG8_WAIT_V(n) asm volatile("s_waitcnt vmcnt(" #n ")" ::: "memory")
#define PG8_WAIT_L(n) asm volatile("s_waitcnt lgkmcnt(" #n ")" ::: "memory")
#define PG8_BAR __builtin_amdgcn_s_barrier()
#define PG8_SCHED __builtin_amdgcn_sched_barrier(0)
    Unit cur, nxt; int ui = 0;
    if (!S.next(0, cur)) return;
    f32x4 acc[2][2][4][2];
#pragma unroll
    for (int a = 0; a < 2; ++a)
#pragma unroll
        for (int b = 0; b < 2; ++b)
#pragma unroll
            for (int m = 0; m < 4; ++m)
#pragma unroll
                for (int n = 0; n < 2; ++n) acc[a][b][m][n] = (f32x4){0.f, 0.f, 0.f, 0.f};
    bf16x8 At[4][2], B0[2][2], B1[2][2];
    const char* cA = (const char*)g.A + cur.aoff; const char* cB = (const char*)g.Bt + cur.boff;
    PG8_STAGE(PG8_SB(0, 0), cB, voffB); PG8_STAGE(PG8_SB(0, 1), cB + hB, voffB); PG8_STAGE(PG8_SA(0, 0), cA, voffA); PG8_STAGE(PG8_SA(0, 1), cA + hA, voffA);
    if (wr == 1) PG8_BAR;
    PG8_WAIT_V(2); PG8_BAR;
    PG8_STAGE(PG8_SB(1, 0), cB + kstep, voffB); PG8_STAGE(PG8_SA(1, 0), cA + kstep, voffA); PG8_STAGE(PG8_SB(1, 1), cB + hB + kstep, voffB);
    PG8_WAIT_V(6); PG8_BAR;
    for (;;) {
        const bool has_next = S.next(ui + 1, nxt);
        const char* nA = has_next ? (const char*)g.A + nxt.aoff : cA; const char* nB = has_next ? (const char*)g.Bt + nxt.boff : cB;
        for (int t = 0; t < nt; t += 2) {
            const bool last = (t == nt - 2);
            const char* a1 = cA + (size_t)(t + 1) * kstep;
            const char* a2 = last ? nA : cA + (size_t)(t + 2) * kstep; const char* b2 = last ? nB : cB + (size_t)(t + 2) * kstep;
            const char* a3 = a2 + kstep; const char* b3 = b2 + kstep;
            PG8_LDB(B0, 0, 0); PG8_LDB(B1, 0, 1); PG8_SCHED; PG8_LDA(At, 0, 0); PG8_STAGE(PG8_SA(1, 1), a1 + hA, voffA);
            PG8_WAIT_V(8); PG8_WAIT_L(0); PG8_BAR; PG8_MMA(0, 0, At, B0); PG8_MMA(0, 1, At, B1); PG8_BAR; PG8_SCHED;
            PG8_LDA(At, 0, 1); PG8_STAGE(PG8_SB(0, 0), b2, voffB); PG8_STAGE(PG8_SB(0, 1), b2 + hB, voffB); PG8_STAGE(PG8_SA(0, 0), a2, voffA);
            PG8_WAIT_V(8); PG8_WAIT_L(0); PG8_BAR; PG8_MMA(1, 0, At, B0); PG8_MMA(1, 1, At, B1); PG8_BAR; PG8_SCHED;
            PG8_LDB(B0, 1, 0); PG8_LDB(B1, 1, 1); PG8_SCHED; PG8_LDA(At, 1, 0); PG8_STAGE(PG8_SA(0, 1), a2 + hA, voffA);
            PG8_WAIT_V(8); PG8_WAIT_L(0); PG8_BAR; PG8_MMA(0, 0, At, B0); PG8_MMA(0, 1, At, B1); PG8_BAR; PG8_SCHED;
            PG8_LDA(At, 1, 1); PG8_STAGE(PG8_SB(1, 0), b3, voffB); PG8_STAGE(PG8_SB(1, 1), b3 + hB, voffB); PG8_STAGE(PG8_SA(1, 0), a3, voffA);
            PG8_WAIT_V(8); PG8_WAIT_L(0); PG8_BAR; PG8_MMA(1, 0, At, B0); PG8_MMA(1, 1, At, B1); PG8_BAR; PG8_SCHED;
        }
        if (wr == 0) PG8_BAR;
        E(acc, cur, wr, wc, fr, fq);
        if (!has_next) break;
#pragma unroll
        for (int a = 0; a < 2; ++a)
#pragma unroll
            for (int b = 0; b < 2; ++b)
#pragma unroll
                for (int m = 0; m < 4; ++m)
#pragma unroll
                    for (int n = 0; n < 2; ++n) acc[a][b][m][n] = (f32x4){0.f, 0.f, 0.f, 0.f};
        cur = nxt; cA = nA; cB = nB; ++ui;
        if (wr == 1) PG8_BAR;
    }
    PG8_WAIT_V(0);
    PG8_BAR;
#undef PG8_SA
#undef PG8_SB
#undef PG8_STAGE
#undef PG8_LDA
#undef PG8_LDB
#undef PG8_MMA
#undef PG8_WAIT_V
#undef PG8_WAIT_L
#undef PG8_BAR
#undef PG8_SCHED
}
}
using pg8::Unit;
typedef f32x4 Acc[2][2][4][2];

struct EpiSwiglu {
    static constexpr bool PERM = true;
    bf16_t* O;
    __device__ __forceinline__ void operator()(const Acc& acc, const Unit& u, int wr, int wc, int fr, int fq) const {
        const int row0 = u.pm * 256 + wr * 64 + fr, col0 = u.pn * 128 + wc * 32 + 8 * fq;
#pragma unroll
        for (int ai = 0; ai < 2; ++ai)
#pragma unroll
            for (int m = 0; m < 4; ++m) {
                const f32x4 a0 = acc[ai][0][m][0], a1 = acc[ai][0][m][1], b0 = acc[ai][1][m][0], b1 = acc[ai][1][m][1];
                u32x4 w;
                w.x = cvt_pk_bf16(silu_f(a0[0]) * b0[0], silu_f(a0[1]) * b0[1]); w.y = cvt_pk_bf16(silu_f(a0[2]) * b0[2], silu_f(a0[3]) * b0[3]);
                w.z = cvt_pk_bf16(silu_f(a1[0]) * b1[0], silu_f(a1[1]) * b1[1]); w.w = cvt_pk_bf16(silu_f(a1[2]) * b1[2], silu_f(a1[3]) * b1[3]);
                *(u32x4*)(O + (size_t)(row0 + ai * 128 + m * 16) * DFF + col0) = w;
            }
    }
};

struct EpiResid {
    static constexpr bool PERM = false;
    const float* base_lat; const float* base_ctx; float* out; const float* gate; float wgt;
    __device__ __forceinline__ void operator()(const Acc& acc, const Unit& u, int wr, int wc, int fr, int fq) const {
        const int bb = u.pm < 256 ? (u.pm >> 5) : 8;
        const float* base = u.pm < 256 ? base_lat + (size_t)u.pm * 256 * D : base_ctx + (size_t)(u.pm - 256) * 256 * D;
        float* o = out + (size_t)u.pm * 256 * D;
        const int col0 = u.pn * 256 + wc * 32 + 4 * fq;
#pragma unroll
        for (int bj = 0; bj < 2; ++bj)
#pragma unroll
            for (int n = 0; n < 2; ++n) { const f32x4 gv = *(const f32x4*)(gate + (size_t)bb * 9 * D + col0 + bj * 128 + n * 16) * wgt;
#pragma unroll
                for (int ai = 0; ai < 2; ++ai) {
#pragma unroll
                    for (int m = 0; m < 4; ++m) { const size_t off = (size_t)(ai * 128 + wr * 64 + m * 16 + fr) * D + col0 + bj * 128 + n * 16;
                        const f32x4 bs = *(const f32x4*)(base + off); *(f32x4*)(o + off) = bs * ALPHA + gv * acc[ai][bj][m][n]; }
                    asm volatile("" ::: "memory"); } }
    }
};

struct EpiRope {
    static constexpr bool PERM = false;
    bf16_t* O; const float* cosT; const float* sinT;
    __device__ __forceinline__ void operator()(const Acc& acc, const Unit& u, int wr, int wc, int fr, int fq) const {
        const bool lat = u.pm < 256;
        const int col0 = u.pn * 256 + wc * 32 + 4 * fq;
        const bool rope_tile = (u.pn == 2 || u.pn == 3 || (u.pn == 4 && lat));
#pragma unroll
        for (int ai = 0; ai < 2; ++ai)
#pragma unroll
            for (int m = 0; m < 4; ++m) {
                const int row = u.pm * 256 + ai * 128 + wr * 64 + m * 16 + fr;
                const int t = row & (SEQ - 1), pos = (wc & 1) ? (t & 63) : (t >> 6);
                f32x4 cs = (f32x4){1.f, 1.f, 1.f, 1.f}, sn = (f32x4){0.f, 0.f, 0.f, 0.f};
                if (rope_tile) { cs = *(const f32x4*)(cosT + pos * 16 + 4 * fq); sn = *(const f32x4*)(sinT + pos * 16 + 4 * fq); }
#pragma unroll
                for (int bj = 0; bj < 2; ++bj) {
                    f32x4 t1 = acc[ai][bj][m][0], t2 = acc[ai][bj][m][1];
                    const bool rot = rope_tile && !(u.pn == 4 && bj == 1);
                    if (rot) { const f32x4 r1 = t1 * cs - t2 * sn, r2 = t1 * sn + t2 * cs; t1 = r1; t2 = r2; }
                    bf16_t* p = O + (size_t)row * INDIM + col0 + bj * 128;
                    u32x2 w1; w1.x = cvt_pk_bf16(t1[0], t1[1]); w1.y = cvt_pk_bf16(t1[2], t1[3]);
                    u32x2 w2; w2.x = cvt_pk_bf16(t2[0], t2[1]); w2.y = cvt_pk_bf16(t2[2], t2[3]);
                    *(u32x2*)p = w1; *(u32x2*)(p + 16) = w2;
                }
            }
    }
};

struct EpiPool {
    static constexpr bool PERM = true;
    bf16_t* O; const float* scale;
    __device__ __forceinline__ void operator()(const Acc& acc, const Unit& u, int wr, int wc, int fr, int fq) const {
        const int row0 = u.pm * 256 + wr * 64 + fr, col0 = u.pn * 256 + wc * 32 + 8 * fq;
#pragma unroll
        for (int bj = 0; bj < 2; ++bj) {
            const f32x4 s0 = *(const f32x4*)(scale + col0 + bj * 128), s1 = *(const f32x4*)(scale + col0 + bj * 128 + 4);
#pragma unroll
            for (int ai = 0; ai < 2; ++ai)
#pragma unroll
                for (int m = 0; m < 4; ++m) { const f32x4 v0 = acc[ai][bj][m][0] * s0, v1 = acc[ai][bj][m][1] * s1;
                    u32x4 w; w.x = cvt_pk_bf16(v0[0], v0[1]); w.y = cvt_pk_bf16(v0[2], v0[3]); w.z = cvt_pk_bf16(v1[0], v1[1]); w.w = cvt_pk_bf16(v1[2], v1[3]);
                    *(u32x4*)(O + (size_t)(row0 + ai * 128 + m * 16) * D + col0 + bj * 128) = w; }
        }
    }
};

struct F1Order { int G, c;
    __device__ bool next(int i, Unit& u) const { const int id = i * G + c; if (id >= 2048) return false; u.pm = id & 1; u.pn = id >> 1;
        const int j = u.pn & 31, g = (u.pn >> 5) & 3, b = u.pn >> 7; u.aoff = (size_t)u.pm * 256 * 256 * 2; u.boff = (((size_t)b * SEQ + 2 * j) * D + g * 256) * 2; return true; } };
struct EpiF1 {
    static constexpr bool PERM = false;
    bf16_t* Yt;
    __device__ __forceinline__ void operator()(const Acc& acc, const Unit& u, int wr, int wc, int fr, int fq) const {
        const int j = u.pn & 31, g = (u.pn >> 5) & 3, b = u.pn >> 7, ri = u.pm;
#pragma unroll
        for (int ai = 0; ai < 2; ++ai)
#pragma unroll
            for (int m = 0; m < 4; ++m) { const int cp = ai * 128 + wr * 64 + m * 16 + fr;
#pragma unroll
                for (int bj = 0; bj < 2; ++bj)
#pragma unroll
                    for (int n = 0; n < 2; ++n) { const int t2 = 2 * j + bj, t1 = 32 * wc + 16 * n + 4 * fq; const f32x4 v = acc[ai][bj][m][n];
                        u32x2 w; w.x = cvt_pk_bf16(v[0], v[1]); w.y = cvt_pk_bf16(v[2], v[3]);
                        *(u32x2*)(Yt + ((((size_t)(g * 256 + cp) * 8 + b) * 64 + t2) * 2 + ri) * 128 + t1) = w; } }
    }
};
struct FAOrder { int G, c;
    __device__ bool next(int i, Unit& u) const { const int id = i * G + c; if (id >= 2048) return false; u.pm = 0; u.pn = id; u.aoff = 0; u.boff = (size_t)id * 256 * 512; return true; } };
struct EpiFA {
    static constexpr bool PERM = false;
    bf16_t* Ut;
    __device__ __forceinline__ void operator()(const Acc& acc, const Unit& u, int wr, int wc, int fr, int fq) const {
        const int b4 = u.pn & 1, cp = (u.pn >> 1) & 255, g = u.pn >> 9;
#pragma unroll
        for (int m = 0; m < 4; ++m) { const int k1 = wr * 64 + m * 16 + fr;
#pragma unroll
            for (int n = 0; n < 2; ++n) { const int t2 = 32 * (wc & 1) + 16 * n + 4 * fq; f32x4 cs, sn; int kk = k1; asm volatile("" : "+v"(kk) :: "memory");
#pragma unroll
                for (int e = 0; e < 4; ++e) { const float rev = (float)(kk * (t2 + e)) * (1.0f / 8192.0f); cs[e] = __builtin_amdgcn_cosf(rev); sn[e] = __builtin_amdgcn_sinf(rev); }
#pragma unroll
                for (int bj = 0; bj < 2; ++bj) { const int b = 4 * b4 + 2 * bj + (wc >> 1); const f32x4 ur = acc[0][bj][m][n], ui = acc[1][bj][m][n];
                    const f32x4 orr = ur * cs + ui * sn, oi = ui * cs - ur * sn;
                    bf16_t* p = Ut + ((((((size_t)(g * 8 + b) * 32 + (kk >> 2)) * 256 + cp) * 4 + (kk & 3)) * 2) * 64) + t2;
                    u32x2 w; w.x = cvt_pk_bf16(orr[0], orr[1]); w.y = cvt_pk_bf16(orr[2], orr[3]); *(u32x2*)p = w;
                    w.x = cvt_pk_bf16(oi[0], oi[1]); w.y = cvt_pk_bf16(oi[2], oi[3]); *(u32x2*)(p + 64) = w; }
                asm volatile("" ::: "memory"); } }
    }
};
struct FCOrder { int G, c;
    __device__ bool next(int i, Unit& u) const { const int id = i * G + c; if (id >= 1024) return false; u.pm = 0; u.pn = id; u.aoff = 0; u.boff = (size_t)id * 256 * 1024; return true; } };
struct EpiFC {
    static constexpr bool PERM = false;
    bf16_t* F;
    __device__ __forceinline__ void operator()(const Acc& acc, const Unit& u, int wr, int wc, int fr, int fq) const {
        const int k1hi = u.pn & 31, b = (u.pn >> 5) & 7, g = u.pn >> 8;
#pragma unroll
        for (int ai = 0; ai < 2; ++ai)
#pragma unroll
            for (int m = 0; m < 4; ++m) { const int k1l = 2 * ai + wr, k2 = 16 * m + fr, tok = 4 * k1hi + k1l + 128 * k2;
#pragma unroll
                for (int bj = 0; bj < 2; ++bj)
#pragma unroll
                    for (int n = 0; n < 2; ++n) { const int cp = 128 * bj + 32 * wc + 16 * n + 4 * fq; const f32x4 v = acc[ai][bj][m][n];
                        u32x2 w; w.x = cvt_pk_bf16(v[0], v[1]); w.y = cvt_pk_bf16(v[2], v[3]);
                        *(u32x2*)(F + ((size_t)b * SEQ + tok) * D + g * 256 + cp) = w; } }
    }
};
struct Ctx {
    LAS unsigned char* lds; int tid, lane, wave, G, bid;
};
#define LDS_WAIT() asm volatile("s_waitcnt lgkmcnt(0)" ::: "memory")

__device__ __forceinline__ void transpose_item(const float* W, int K, int N, bf16_t* WT, int ldo, int k0, int n0, int orow0, LAS float* scr, int lane) {
#pragma unroll 8
    for (int i = 0; i < 32; ++i) { const int kk = 2 * i + (lane >> 5); scr[kk * 33 + (lane & 31)] = W[(size_t)(k0 + kk) * N + n0 + (lane & 31)]; }
    LDS_WAIT(); asm volatile("" ::: "memory");
    const int c = lane & 7;
#pragma unroll
    for (int j = 0; j < 4; ++j) { const int n = (lane >> 3) + 8 * j; const LAS float* s = scr + (8 * c) * 33 + n;
        u32x4 o; o.x = pk2(s[0 * 33], s[1 * 33]); o.y = pk2(s[2 * 33], s[3 * 33]); o.z = pk2(s[4 * 33], s[5 * 33]); o.w = pk2(s[6 * 33], s[7 * 33]);
        *(u32x4*)(WT + (size_t)(orow0 + n) * ldo + k0 + 8 * c) = o; }
    LDS_WAIT(); asm volatile("" ::: "memory");
}

struct In {
    const float *x, *c, *ctx, *c_ctx, *ada_w, *ada_b, *ln_g, *ln_b, *f1w1, *f1w3, *f1w2, *f2w1, *f2w3, *f2w2, *w_in, *pool_w, *pool_scale, *sinks, *w_out, *fw_out;
};

__device__ __forceinline__ void p0_mod(const Ctx& X, const In& I, float* MOD) {
    LAS float* S = (LAS float*)X.lds;
    LAS float* R = (LAS float*)(X.lds + 9 * 1024 * 4);
    if (X.bid >= 288) return;
    for (int i = X.tid; i < 9 * 1024; i += 512) { const float v = i < 8 * 1024 ? I.c[i] : I.c_ctx[i - 8 * 1024]; S[i] = v / (1.0f + __expf(-v)); }
    __syncthreads();
    for (int item = X.bid; item < 288; item += X.G) {
        const int l = item / 144, n = (item % 144) * 64 + (X.tid & 63), ks = X.tid >> 6;
        float a[9];
#pragma unroll
        for (int b = 0; b < 9; ++b) a[b] = 0.f;
        const float* w = I.ada_w + (size_t)l * D * 9 * D + n;
        for (int k = ks * 128; k < ks * 128 + 128; ++k) { const float wv = w[(size_t)k * 9 * D];
#pragma unroll
            for (int b = 0; b < 9; ++b) a[b] += S[b * 1024 + k] * wv; }
#pragma unroll
        for (int b = 0; b < 9; ++b) R[(ks * 9 + b) * 64 + (X.tid & 63)] = a[b];
        __syncthreads();
        for (int o = X.tid; o < 9 * 64; o += 512) { const int b = o >> 6, cc = o & 63; float s = 0.f;
#pragma unroll
            for (int k2 = 0; k2 < 8; ++k2) s += R[(k2 * 9 + b) * 64 + cc];
            const int nn = (item % 144) * 64 + cc; MOD[((size_t)l * 9 + b) * 9 * D + nn] = s + I.ada_b[(size_t)l * 9 * D + nn]; }
        __syncthreads();
    }
}
__device__ __forceinline__ void p0_weights(const Ctx& X, const In& I, const float* const* inp, unsigned char* ws) {
    LAS float* scr = (LAS float*)(X.lds + 65536 + X.wave * 8704);
    const int gw = X.bid * 8 + X.wave, NGW = X.G * 8;
    constexpr int I_UP = 16 * 88, I_DN = 44 * 32, I_IN = 16 * 40, I_SQ = 16 * 32;
    constexpr int NITEMS = 8 * I_UP + 4 * I_DN + I_IN + 2 * I_SQ;
    for (int it = gw; it < NITEMS; it += NGW) {
        int r = it;
        if (r < 8 * I_UP) { const int which = r / I_UP, q = r % I_UP, kb = q / 88, nb = q % 88, lf = which >> 1, w13 = which & 1;
            const float* src = inp[8 + 3 * (lf & 1) + w13] + (size_t)(lf >> 1) * D * DFF;
            const int n0 = nb * 32; transpose_item(src, D, DFF, (bf16_t*)(ws + WS_WUP + (size_t)lf * WUP_SZ), D, kb * 64, n0, (n0 >> 7) * 256 + w13 * 128 + (n0 & 127), scr, X.lane); continue; }
        r -= 8 * I_UP;
        if (r < 4 * I_DN) { const int lf = r / I_DN, q = r % I_DN, kb = q / 32, nb = q % 32;
            const float* src = inp[10 + 3 * (lf & 1)] + (size_t)(lf >> 1) * DFF * D;
            transpose_item(src, DFF, D, (bf16_t*)(ws + WS_WDN + (size_t)lf * WDN_SZ), DFF, kb * 64, nb * 32, nb * 32, scr, X.lane); continue; }
        r -= 4 * I_DN;
        if (r < I_IN) { const int kb = r / 40, nb = r % 40; transpose_item(I.w_in, D, INDIM, (bf16_t*)(ws + WS_WIN), D, kb * 64, nb * 32, nb * 32, scr, X.lane); continue; }
        r -= I_IN;
        if (r < I_SQ) { const int kb = r / 32, nb = r % 32; transpose_item(I.w_out, D, D, (bf16_t*)(ws + WS_WOUT), D, kb * 64, nb * 32, nb * 32, scr, X.lane); continue; }
        r -= I_SQ;
        { const int kb = r / 32, nb = r % 32; transpose_item(I.fw_out, D, D, (bf16_t*)(ws + WS_WF), D, kb * 64, nb * 32, nb * 32, scr, X.lane); }
    }
    const int gt = X.bid * 512 + X.tid, NGT = X.G * 512;
    bf16_t* Wp = (bf16_t*)(ws + WS_WPBD);
    for (int i = gt; i < 512 * 512; i += NGT) { const int n = i >> 9, k = i & 511; Wp[i] = ((n >> 7) == (k >> 7)) ? (bf16_t)f2bf(I.pool_w[((size_t)(n >> 7) * 128 + (k & 127)) * 128 + (n & 127)]) : (bf16_t)0; }
    bf16_t* Wch = (bf16_t*)(ws + WS_WCH);
    for (int i = gt; i < 512 * 256; i += NGT) { const int m = i >> 8, c = i & 255, cp = m & 255, ri = m >> 8; const float rev = (float)((c * cp) & 255) * (1.0f / 256.0f);
        const float v = ri ? -__builtin_amdgcn_sinf(rev) : __builtin_amdgcn_cosf(rev); Wch[i] = (bf16_t)f2bf(v * 0.0625f); }
    bf16_t* WA = (bf16_t*)(ws + WS_WA);
    for (int i = gt; i < 256 * 256; i += NGT) { const int m = i >> 8, kk = i & 255, ro = m >> 7, k1 = m & 127, ri = kk >> 7, t1 = kk & 127; const float rev = (float)((k1 * t1) & 127) * (1.0f / 128.0f);
        const float cs = __builtin_amdgcn_cosf(rev), sn = __builtin_amdgcn_sinf(rev); const float v = (ro == ri) ? cs : (ro == 0 ? sn : -sn); WA[i] = (bf16_t)f2bf(v * 0.08838834764f); }
    bf16_t* WC = (bf16_t*)(ws + WS_WC);
    for (int i = gt; i < 256 * 512; i += NGT) { const int m = i >> 9, kk = i & 511, k1l = m >> 6, k2 = m & 63, k1lp = kk >> 7, ri = (kk >> 6) & 1, t2 = kk & 63; const float rev = (float)((k2 * t2) & 63) * (1.0f / 64.0f);
        const float v = (k1l == k1lp) ? (ri ? __builtin_amdgcn_sinf(rev) : __builtin_amdgcn_cosf(rev)) * 0.125f : 0.f; WC[i] = (bf16_t)f2bf(v); }
    float* cosT = (float*)(ws + WS_ROPE); float* sinT = cosT + 2048;
    for (int i = gt; i < 2048; i += NGT) { const int pos = i >> 4, jj = i & 15; const float freq = __builtin_amdgcn_exp2f(-(float)jj * (13.2877123795f / 16.0f));
        const float ang = (float)pos * freq, rev = ang * 0.15915494309f, fr_ = rev - floorf(rev); cosT[i] = __builtin_amdgcn_cosf(fr_); sinT[i] = __builtin_amdgcn_sinf(fr_); }
}

template <bool AFF, bool MODU>
__device__ __forceinline__ void row_pass(const Ctx& X, int nrows, const float* zin_lat, const float* zin_ctx, float* xout, const float* lng, const float* lnb, const float* shv, const float* scv, bf16_t* H) {
    int lane_ = threadIdx.x & 63; asm volatile("" : "+v"(lane_)); const int lane = lane_;
    const int gw = X.bid * 8 + X.wave, NGW = X.G * 8;
    for (int row = gw; row < nrows; row += NGW) {
        const float* zr = row < MLAT ? zin_lat + (size_t)row * D : zin_ctx + (size_t)(row - MLAT) * D;
        f32x4 v[4]; float s = 0.f;
#pragma unroll
        for (int j = 0; j < 4; ++j) { v[j] = *(const f32x4*)(zr + 4 * lane + 256 * j); s += (v[j][0] + v[j][1]) + (v[j][2] + v[j][3]); }
        if (AFF) {
            const float mean = wave_sum(s) * (1.f / D); float s2 = 0.f;
#pragma unroll
            for (int j = 0; j < 4; ++j) { v[j] = v[j] - mean; s2 += (v[j][0] * v[j][0] + v[j][1] * v[j][1]) + (v[j][2] * v[j][2] + v[j][3] * v[j][3]); }
            const float rstd = 1.0f / sqrtf(wave_sum(s2) * (1.f / D) + LN_EPS);
            s = 0.f;
#pragma unroll
            for (int j = 0; j < 4; ++j) { const f32x4 gg = *(const f32x4*)(lng + 4 * lane + 256 * j), bb = *(const f32x4*)(lnb + 4 * lane + 256 * j);
                v[j] = v[j] * rstd * gg + bb; *(f32x4*)(xout + (size_t)row * D + 4 * lane + 256 * j) = v[j]; s += (v[j][0] + v[j][1]) + (v[j][2] + v[j][3]); }
        }
        if (MODU) {
            const int bb = row < MLAT ? (row >> 13) : 8;
            const float mean = wave_sum(s) * (1.f / D); float s2 = 0.f;
#pragma unroll
            for (int j = 0; j < 4; ++j) { v[j] = v[j] - mean; s2 += (v[j][0] * v[j][0] + v[j][1] * v[j][1]) + (v[j][2] * v[j][2] + v[j][3] * v[j][3]); }
            const float rstd = 1.0f / sqrtf(wave_sum(s2) * (1.f / D) + LN_EPS);
#pragma unroll
            for (int j = 0; j < 4; ++j) { const f32x4 sh = *(const f32x4*)(shv + (size_t)bb * 9 * D + 4 * lane + 256 * j), sc = *(const f32x4*)(scv + (size_t)bb * 9 * D + 4 * lane + 256 * j);
                const f32x4 o = v[j] * rstd * (sc + 1.0f) + sh; u32x2 w; w.x = pk2(o[0], o[1]); w.y = pk2(o[2], o[3]);
                *(u32x2*)(H + (size_t)row * D + 4 * lane + 256 * j) = w; }
        }
    }
}

__device__ __forceinline__ void pool_diff(const Ctx& X, const bf16_t* U, bf16_t* PD) {
    int tid_ = threadIdx.x; asm volatile("" : "+v"(tid_));
    const int gt = X.bid * 512 + tid_, NGT = X.G * 512;
    for (int item = gt; item < MLAT * 64; item += NGT) {
        const int row = item >> 6, c0 = (item & 63) * 8, g = c0 >> 7, hw = 1 << g, t = row & (SEQ - 1);
        const int lo = (t - hw) < 0 ? 0 : (t - hw), hi = (t + hw) > SEQ ? SEQ : (t + hw);
        float a[8];
#pragma unroll
        for (int e = 0; e < 8; ++e) a[e] = 0.f;
        const bf16_t* base = U + (size_t)(row - t) * INDIM + c0;
        for (int tt = lo; tt < hi; ++tt) { const u32x4 w = *(const u32x4*)(base + (size_t)tt * INDIM);
#pragma unroll
            for (int e = 0; e < 4; ++e) { a[2 * e] += bf2f(w[e]); a[2 * e + 1] += bf2f(w[e] >> 16); } }
        const float inv = 1.0f / (float)(hi - lo);
        const u32x4 sw = *(const u32x4*)(base + (size_t)t * INDIM); u32x4 o;
#pragma unroll
        for (int e = 0; e < 4; ++e) o[e] = pk2(a[2 * e] * inv - bf2f(sw[e]), a[2 * e + 1] * inv - bf2f(sw[e] >> 16));
        *(u32x4*)(PD + (size_t)row * 512 + c0) = o;
    }
}

__device__ __forceinline__ void attn_phase(const Ctx& X, const bf16_t* U, bf16_t* AO, const float* sinks) {
    int tid_ = threadIdx.x; asm volatile("" : "+v"(tid_));
    const int wid = X.wave, lane = tid_ & 63, fr = lane & 15, fq = lane >> 4;
    LAS bf16_t* Ks = (LAS bf16_t*)X.lds;
    LAS bf16_t* Vt = (LAS bf16_t*)(X.lds + 128 * 72 * 2);
    const float SC = 0.125f * LOG2E;
    for (int unit = X.bid; unit < 2048; unit += X.G) {
        const int half = unit & 1, blk = (unit >> 1) & 63, hkv = (unit >> 7) & 1, b = unit >> 8;
        const int hq = hkv * 4 + (wid >> 1), qi0 = half * 64 + (wid & 1) * 32;
        const size_t qrow0 = (size_t)b * SEQ + blk * 128 + qi0;
        float m_run[2], l_run[2]; f32x4 o[2][4];
        const float sk = sinks[hq] * LOG2E;
#pragma unroll
        for (int qg = 0; qg < 2; ++qg) { m_run[qg] = sk; l_run[qg] = 1.0f;
#pragma unroll
            for (int db = 0; db < 4; ++db) o[qg][db] = (f32x4){0.f, 0.f, 0.f, 0.f}; }
#pragma unroll 1
        for (int c = 0; c < 5; ++c) {
            if ((c == 0 && blk == 0) || (c == 2 && blk == 63)) continue;
            const size_t krow0 = c < 3 ? (size_t)b * SEQ + (size_t)(blk - 1 + c) * 128 : (size_t)MLAT + b * NCTX + (c - 3) * 128;
            __syncthreads();
#pragma unroll
            for (int i = 0; i < 2; ++i) { const int p = tid_ + 512 * i, key = p >> 3, dp = p & 7;
                const bf16_t* src = U + (krow0 + key) * INDIM + 1024 + hkv * 64 + 8 * dp;
                const u32x4 kv = *(const u32x4*)src, vv = *(const u32x4*)(src + 128);
                *(LAS u32x4*)(Ks + key * 72 + 8 * dp) = kv;
#pragma unroll
                for (int e = 0; e < 4; ++e) { Vt[(8 * dp + 2 * e) * 136 + key] = (bf16_t)(vv[e] & 0xffffu); Vt[(8 * dp + 2 * e + 1) * 136 + key] = (bf16_t)(vv[e] >> 16); } }
            __syncthreads();
            f32x4 s[2][8];
            bf16x8 qf[2][2];
#pragma unroll
            for (int qg = 0; qg < 2; ++qg)
#pragma unroll
                for (int ks = 0; ks < 2; ++ks) qf[qg][ks] = *(const bf16x8*)(U + (qrow0 + 16 * qg + fr) * INDIM + 512 + hq * 64 + 32 * ks + 8 * fq);
#pragma unroll
            for (int kb = 0; kb < 8; ++kb) {
                const bf16x8 k0 = *(const LAS bf16x8*)(Ks + (16 * kb + fr) * 72 + 8 * fq), k1 = *(const LAS bf16x8*)(Ks + (16 * kb + fr) * 72 + 32 + 8 * fq);
#pragma unroll
                for (int qg = 0; qg < 2; ++qg) { f32x4 z = (f32x4){0.f, 0.f, 0.f, 0.f};
                    z = __builtin_amdgcn_mfma_f32_16x16x32_bf16(k0, qf[qg][0], z, 0, 0, 0); s[qg][kb] = __builtin_amdgcn_mfma_f32_16x16x32_bf16(k1, qf[qg][1], z, 0, 0, 0); }
            }
#pragma unroll
            for (int qg = 0; qg < 2; ++qg) {
                const int q_idx = qi0 + 16 * qg + fr; float mx = -INFINITY;
#pragma unroll
                for (int kb = 0; kb < 8; ++kb)
#pragma unroll
                    for (int e = 0; e < 4; ++e) { const int k_idx = 16 * kb + 4 * fq + e; float v = s[qg][kb][e] * SC;
                        const bool valid = (c == 0) ? (k_idx >= q_idx) : ((c == 2) ? (k_idx <= q_idx) : true);
                        v = valid ? v : -INFINITY; s[qg][kb][e] = v; mx = fmaxf(mx, v); }
                mx = fmaxf(mx, __shfl_xor(mx, 16)); mx = fmaxf(mx, __shfl_xor(mx, 32));
                const float m_new = fmaxf(m_run[qg], mx), alpha = __builtin_amdgcn_exp2f(m_run[qg] - m_new); m_run[qg] = m_new;
                float rs = 0.f;
#pragma unroll
                for (int kb = 0; kb < 8; ++kb)
#pragma unroll
                    for (int e = 0; e < 4; ++e) { const float p = __builtin_amdgcn_exp2f(s[qg][kb][e] - m_new); s[qg][kb][e] = p; rs += p; }
                rs += __shfl_xor(rs, 16); rs += __shfl_xor(rs, 32);
                l_run[qg] = l_run[qg] * alpha + rs;
#pragma unroll
                for (int db = 0; db < 4; ++db) o[qg][db] = o[qg][db] * alpha;
            }
#pragma unroll
            for (int kg = 0; kg < 4; ++kg) {
                bf16x8 pf[2];
#pragma unroll
                for (int qg = 0; qg < 2; ++qg) { u32x4 w; w.x = cvt_pk_bf16(s[qg][2 * kg][0], s[qg][2 * kg][1]); w.y = cvt_pk_bf16(s[qg][2 * kg][2], s[qg][2 * kg][3]);
                    w.z = cvt_pk_bf16(s[qg][2 * kg + 1][0], s[qg][2 * kg + 1][1]); w.w = cvt_pk_bf16(s[qg][2 * kg + 1][2], s[qg][2 * kg + 1][3]); pf[qg] = __builtin_bit_cast(bf16x8, w); }
#pragma unroll
                for (int db = 0; db < 4; ++db) {
                    const LAS bf16_t* vp = Vt + (16 * db + fr) * 136 + 32 * kg + 4 * fq;
                    const u32x2 v0 = *(const LAS u32x2*)vp, v1 = *(const LAS u32x2*)(vp + 16);
                    u32x4 vw; vw.x = v0.x; vw.y = v0.y; vw.z = v1.x; vw.w = v1.y; const bf16x8 vf = __builtin_bit_cast(bf16x8, vw);
#pragma unroll
                    for (int qg = 0; qg < 2; ++qg) o[qg][db] = __builtin_amdgcn_mfma_f32_16x16x32_bf16(vf, pf[qg], o[qg][db], 0, 0, 0);
                }
            }
        }
#pragma unroll
        for (int qg = 0; qg < 2; ++qg) { const float inv = 1.0f / l_run[qg]; bf16_t* op = AO + (qrow0 + 16 * qg + fr) * D + 512 + hq * 64 + 4 * fq;
#pragma unroll
            for (int db = 0; db < 4; ++db) { const f32x4 v = o[qg][db] * inv; u32x2 w; w.x = cvt_pk_bf16(v[0], v[1]); w.y = cvt_pk_bf16(v[2], v[3]); *(u32x2*)(op + 16 * db) = w; } }
    }
}
struct Args { const float* in[20]; float* out; unsigned char* ws; };
__device__ __forceinline__ const float* ld_in(const Args& a, int i) { asm volatile("" : "+s"(i)); return a.in[i]; }
__device__ __forceinline__ unsigned char* ld_ws(const Args& a) { int z = 0; asm volatile("" : "+s"(z)); return (&a.ws)[z]; }
__device__ __forceinline__ float* ld_out(const Args& a) { int z = 0; asm volatile("" : "+s"(z)); return (&a.out)[z]; }
constexpr int LDS_BYTES = 147456;

__global__ void __launch_bounds__(512, 2) fwd_kernel(Args args) {
    extern __shared__ __attribute__((aligned(16))) unsigned char lds_raw[];
    cg::grid_group grid = cg::this_grid();
    Ctx X; X.lds = (LAS unsigned char*)lds_raw; X.tid = threadIdx.x; X.lane = X.tid & 63; X.wave = __builtin_amdgcn_readfirstlane(X.tid >> 6); X.G = gridDim.x; X.bid = blockIdx.x;
#define INP(i) ld_in(args, (i))
#define WSP() ld_ws(args)
#define MOD ((float*)(WSP() + WS_MOD))
#define Z ((float*)(WSP() + WS_Z))
#define H ((bf16_t*)(WSP() + WS_H))
#define HID ((bf16_t*)(WSP() + WS_HID))
#define UIN ((bf16_t*)(WSP() + WS_UIN))
#define PD ((bf16_t*)(WSP() + WS_PD))
#define AO ((bf16_t*)(WSP() + WS_AO))
#define YT ((bf16_t*)(WSP() + WS_YT))
#define UT ((bf16_t*)(WSP() + WS_UT))
#define FB ((bf16_t*)(WSP() + WS_F))
#define MODP(l, chunk) (MOD + ((size_t)(l) * 81 + (chunk)) * D)
#define SYNC() grid.sync()

    { In I; I.c = INP(1); I.c_ctx = INP(3); I.ada_w = INP(4); I.ada_b = INP(5); I.w_in = INP(14); I.pool_w = INP(15); I.w_out = INP(18); I.fw_out = INP(19);
      p0_mod(X, I, MOD); p0_weights(X, I, args.in, WSP()); }
    SYNC();
    row_pass<false, true>(X, MR, INP(0), INP(2), nullptr, nullptr, nullptr, MODP(0, 0), MODP(0, 1), H);
    SYNC();

#pragma unroll 1
    for (int s = 0; s < 4; ++s) {
        const int l = s >> 1, f = s & 1, Mrows = (s == 0) ? MR : MLAT;
        { pg8::Gemm g{H, (const bf16_t*)(WSP() + WS_WUP + (size_t)s * WUP_SZ), D, 2048u, 2048u, (size_t)128 * 2048, (size_t)128 * 2048};
          pg8::StdOrder S; S.init(Mrows, NUP, X.G, X.bid, (size_t)256 * 2048, (size_t)256 * 2048);
          EpiSwiglu E{HID}; pg8::gemm_phase(X.lds, g, S, E); }
        SYNC();
        { pg8::Gemm g{HID, (const bf16_t*)(WSP() + WS_WDN + (size_t)s * WDN_SZ), DFF, 5632u, 5632u, (size_t)128 * 5632, (size_t)128 * 5632};
          pg8::StdOrder S; S.init(Mrows, D, X.G, X.bid, (size_t)256 * 5632, (size_t)256 * 5632);
          EpiResid E{s == 0 ? INP(0) : Z, s == 0 ? INP(2) : Z + (size_t)MLAT * D, Z, MODP(l, f ? 8 : 2), 0.5f}; pg8::gemm_phase(X.lds, g, S, E); }
        SYNC();
        if (s == 3) { row_pass<true, false>(X, MLAT, Z, Z, ld_out(args), INP(6) + (size_t)(l * 3 + 2) * D, INP(7) + (size_t)(l * 3 + 2) * D, nullptr, nullptr, nullptr); break; }
        { const int j = f ? 2 : 0; const int ml = (s == 1) ? 1 : l, mc = (s == 1) ? 0 : 3;
          row_pass<true, true>(X, Mrows, Z, Z + (size_t)MLAT * D, Z, INP(6) + (size_t)(l * 3 + j) * D, INP(7) + (size_t)(l * 3 + j) * D, MODP(ml, mc), MODP(ml, mc + 1), H); }
        SYNC();
        if (f == 1) continue;
        if (l == 0) {
            { pg8::Gemm g{H, (const bf16_t*)(WSP() + WS_WIN), D, 2048u, 2048u, (size_t)128 * 2048, (size_t)128 * 2048};
              pg8::StdOrder S; S.init(MR, INDIM, X.G, X.bid, (size_t)256 * 2048, (size_t)256 * 2048);
              EpiRope E{UIN, (const float*)(WSP() + WS_ROPE), (const float*)(WSP() + WS_ROPE) + 2048}; pg8::gemm_phase(X.lds, g, S, E); }
            SYNC();
            pool_diff(X, UIN, PD);
            attn_phase(X, UIN, AO, INP(17));
            SYNC();
            { pg8::Gemm g{PD, (const bf16_t*)(WSP() + WS_WPBD), 512, 1024u, 1024u, (size_t)128 * 1024, (size_t)128 * 1024};
              pg8::StdOrder S; S.init(MLAT, 512, X.G, X.bid, (size_t)256 * 1024, (size_t)256 * 1024);
              EpiPool E{AO, INP(16)}; pg8::gemm_phase(X.lds, g, S, E); }
            SYNC();
            { pg8::Gemm g{AO, (const bf16_t*)(WSP() + WS_WOUT), D, 2048u, 2048u, (size_t)128 * 2048, (size_t)128 * 2048};
              pg8::StdOrder S; S.init(MLAT, D, X.G, X.bid, (size_t)256 * 2048, (size_t)256 * 2048);
              EpiResid E{Z, Z, Z, MODP(0, 5), 1.0f}; pg8::gemm_phase(X.lds, g, S, E); }
        } else {
            { pg8::Gemm g{(const bf16_t*)(WSP() + WS_WCH), H, 256, 512u, 131072u, (size_t)128 * 512, (size_t)2048};
              F1Order S{X.G, X.bid}; EpiF1 E{YT}; pg8::gemm_phase(X.lds, g, S, E); }
            SYNC();
            { pg8::Gemm g{(const bf16_t*)(WSP() + WS_WA), YT, 256, 512u, 512u, (size_t)128 * 512, (size_t)128 * 512};
              FAOrder S{X.G, X.bid}; EpiFA E{UT}; pg8::gemm_phase(X.lds, g, S, E); }
            SYNC();
            { pg8::Gemm g{(const bf16_t*)(WSP() + WS_WC), UT, 512, 1024u, 1024u, (size_t)128 * 1024, (size_t)128 * 1024};
              FCOrder S{X.G, X.bid}; EpiFC E{FB}; pg8::gemm_phase(X.lds, g, S, E); }
            SYNC();
            { pg8::Gemm g{FB, (const bf16_t*)(WSP() + WS_WF), D, 2048u, 2048u, (size_t)128 * 2048, (size_t)128 * 2048};
              pg8::StdOrder S; S.init(MLAT, D, X.G, X.bid, (size_t)256 * 2048, (size_t)256 * 2048);
              EpiResid E{Z, Z, Z, MODP(1, 5), 1.0f}; pg8::gemm_phase(X.lds, g, S, E); }
        }
        SYNC();
        row_pass<true, true>(X, MLAT, Z, Z, Z, INP(6) + (size_t)(l * 3 + 1) * D, INP(7) + (size_t)(l * 3 + 1) * D, MODP(l, 6), MODP(l, 7), H);
        SYNC();
    }
}

extern "C" void kernel_launch(void* const* d_in, const int* in_sizes, int n_in, void* d_out, int out_size, void* d_ws, size_t ws_size, hipStream_t stream) {
    static int grid = 0;
    if (grid == 0) {
        if (n_in != 20 || out_size != MLAT * D || ws_size < WS_END) { fprintf(stderr, "kernel_launch: unexpected problem: n_in %d out %d ws %zu (need %zu)\n", n_in, out_size, ws_size, (size_t)WS_END); grid = -1; return; }
        int dev = 0, cus = 0, per_cu = 0;
        (void)hipGetDevice(&dev); (void)hipDeviceGetAttribute(&cus, hipDeviceAttributeMultiprocessorCount, dev);
        (void)hipFuncSetAttribute((const void*)fwd_kernel, hipFuncAttributeMaxDynamicSharedMemorySize, LDS_BYTES);
        (void)hipOccupancyMaxActiveBlocksPerMultiprocessor(&per_cu, (const void*)fwd_kernel, 512, LDS_BYTES);
        if (per_cu < 1) per_cu = 1;
        grid = cus * per_cu;
        fprintf(stderr, "kernel_launch: %d CUs x %d = grid %d\n", cus, per_cu, grid);
    }
    if (grid < 0) return;
    Args a{};
    for (int i = 0; i < 20; ++i) a.in[i] = (const float*)d_in[i];
    a.out = (float*)d_out; a.ws = (unsigned char*)d_ws;
    void* kargs[] = {&a};
    hipError_t e = hipLaunchCooperativeKernel((const void*)fwd_kernel, dim3(grid), dim3(512), kargs, LDS_BYTES, stream);
    if (e != hipSuccess) fprintf(stderr, "kernel_launch: cooperative launch failed: %s (grid %d)\n", hipGetErrorString(e), grid);
}
```

```cpp
#include <hip/hip_runtime.h>
#include <hip/hip_cooperative_groups.h>
#include <cstdio>
#include <cstdint>
namespace cg = cooperative_groups;

#ifndef CHK
#define CHK 0
#endif

#define LAS __attribute__((address_space(3)))
typedef unsigned short bf16_t;
typedef short bf16x8 __attribute__((ext_vector_type(8)));
typedef short s16x4 __attribute__((ext_vector_type(4)));
typedef float f32x4 __attribute__((ext_vector_type(4)));
typedef float f32x2 __attribute__((ext_vector_type(2)));
typedef unsigned u32x4 __attribute__((ext_vector_type(4)));
typedef unsigned u32x2 __attribute__((ext_vector_type(2)));

constexpr int D = 1024, NBATCH = 8, SEQ = 8192, MLAT = NBATCH * SEQ, NCTX = 256, MCTX = NBATCH * NCTX, MR = MLAT + MCTX;
constexpr int DFF = 2816, NUP = 2 * DFF, INDIM = 1280;
constexpr float ALPHA = 1.41421356237f, LN_EPS = 1e-5f, LOG2E = 1.44269504089f;
constexpr size_t MiB = 1u << 20;
constexpr size_t WS_CTL = 0, WS_MOD = 1 * MiB, WS_ROPE = 2 * MiB, WS_WCH = 2 * MiB + 65536, WS_WA = WS_WCH + 262144, WS_WC = WS_WA + 131072, WS_WPBD = 3 * MiB;
constexpr size_t WS_WUP = 4 * MiB, WUP_SZ = (size_t)NUP * D * 2, WS_WDN = 48 * MiB, WDN_SZ = (size_t)D * DFF * 2, WS_WIN = 70 * MiB, WS_WOUT = 73 * MiB, WS_WF = 75 * MiB;
constexpr size_t WS_Z = 88 * MiB, WS_HID = 352 * MiB, WS_H = 715 * MiB, WS_END = 1024 * MiB;
constexpr size_t WS_UIN = WS_HID, WS_PD = 517 * MiB, WS_AO = 581 * MiB;
constexpr size_t WS_YT = WS_HID, WS_UT = WS_H, WS_F = WS_HID;
static_assert(WS_WUP + 4 * WUP_SZ <= WS_WDN && WS_WDN + 4 * WDN_SZ <= WS_WIN && WS_Z + (size_t)MR * D * 4 <= WS_HID && WS_HID + (size_t)MR * DFF * 2 <= WS_H && WS_H + (size_t)MR * D * 2 <= WS_END, "ws map");
static_assert(WS_UIN + (size_t)MR * INDIM * 2 <= WS_PD && WS_PD + (size_t)MLAT * 512 * 2 <= WS_AO && WS_AO + (size_t)MLAT * D * 2 <= WS_H && WS_UT + (size_t)MLAT * 2048 * 2 <= WS_END, "ws overlays");

__device__ __forceinline__ unsigned f2bf(float f) { unsigned u = __builtin_bit_cast(unsigned, f); return (u + 0x7fffu + ((u >> 16) & 1u)) >> 16; }
__device__ __forceinline__ unsigned pk2(float lo, float hi) { return f2bf(lo) | (f2bf(hi) << 16); }
__device__ __forceinline__ float bf2f(unsigned v) { return __builtin_bit_cast(float, (v & 0xffffu) << 16); }
__device__ __forceinline__ unsigned cvt_pk_bf16(float lo, float hi) { unsigned r; asm volatile("v_cvt_pk_bf16_f32 %0, %1, %2" : "=v"(r) : "v"(lo), "v"(hi)); return r; }
__device__ __forceinline__ float silu_f(float a) { return a * __builtin_amdgcn_rcpf(1.0f + __builtin_amdgcn_exp2f(-a * LOG2E)); }
__device__ __forceinline__ float wave_sum(float v) {
#pragma unroll
    for (int o = 1; o < 64; o <<= 1) v += __shfl_xor(v, o);
    return v;
}

namespace pg8 {
constexpr int BM = 256, BK = 64, HALF = 128, HTB = HALF * BK * 2, STAGE_BYTES = 8 * HTB, NXCD = 8, WGM = 8;
__device__ __forceinline__ int lds_byte(int r, int c) { const int st = (r >> 4) * 2 + (c >> 5), rr = r & 15, cc = c & 31, ob = rr * 64 + cc * 2; return st * 1024 + (ob ^ (((ob >> 9) & 1) << 5)); }
__device__ __forceinline__ void stage_rc(int b, int& R, int& C) { const int st = b / 1024, sb = b % 1024, swz = sb ^ (((sb >> 9) & 1) << 5); R = (st >> 1) * 16 + swz / 64; C = (st & 1) * 32 + (swz % 64) / 2; }
__device__ __forceinline__ int perm32(int rho) { const int n = rho >> 4, i = rho & 15; return 8 * (i >> 2) + 4 * n + (i & 3); }

struct Unit { int pm, pn; size_t aoff, boff; };
struct Gemm { const bf16_t* A; const bf16_t* Bt; int K; unsigned a_row, b_row; size_t a_half, b_half; };

struct StdOrder {
    int nM, nN, nwg, G, c; size_t a_tile, b_tile;
    __device__ void init(int M, int N, int G_, int c_, size_t at, size_t bt) { nM = M / BM; nN = N / BM; nwg = nM * nN; G = G_; c = c_; a_tile = at; b_tile = bt; }
    __device__ bool next(int i, Unit& u) const {
        const long L = (long)i * G + c; if (L >= nwg) return false;
        int wgid = (int)L; { const int q = nwg / NXCD, r = nwg % NXCD, xcd = wgid % NXCD, off = wgid / NXCD; wgid = (xcd < r ? xcd * (q + 1) : r * (q + 1) + (xcd - r) * q) + off; }
        const int nig = WGM * nN, gid = wgid / nig, fm = gid * WGM, gsz = (nM - fm) < WGM ? (nM - fm) : WGM;
        u.pm = fm + ((wgid % nig) % gsz); u.pn = (wgid % nig) / gsz; u.aoff = (size_t)u.pm * a_tile; u.boff = (size_t)u.pn * b_tile; return true;
    }
};

template <class Epi, class Sched>
__device__ __forceinline__ void gemm_phase(LAS unsigned char* lds, const Gemm g, const Sched& S, const Epi& E) {
    int tid_ = threadIdx.x; asm volatile("" : "+v"(tid_));
    const int tid = tid_, wid = __builtin_amdgcn_readfirstlane(tid >> 6), lane = tid & 63, wr = wid >> 2, wc = wid & 3, fr = lane & 15, fq = lane >> 4;
    int K_ = g.K; asm volatile("" : "+s"(K_));
    const int K = K_, nt = K / BK;
    unsigned voffA[2], voffB[2];
#pragma unroll
    for (int i = 0; i < 2; ++i) { int R, C; stage_rc(tid * 16 + i * 8192, R, C); const int Rb = Epi::PERM ? ((R & ~31) + perm32(R & 31)) : R;
        voffA[i] = (unsigned)R * g.a_row + (unsigned)C * 2u; voffB[i] = (unsigned)Rb * g.b_row + (unsigned)C * 2u; }
    const size_t kstep = (size_t)(BK * 2);
    const size_t hA = g.a_half, hB = g.b_half;
    const unsigned ldsw = (unsigned)wid * 1024u;
    const int aoff = lds_byte(wr * 64 + fr, fq * 8), boff = lds_byte(wc * 32 + fr, fq * 8);
#define PG8_SA(b, h) (((b) * 2 + (h)) * HTB)
#define PG8_SB(b, h) ((4 + (b) * 2 + (h)) * HTB)
#define PG8_STAGE(bufoff, gbase, voff) do { _Pragma("unroll") for (int _i = 0; _i < 2; ++_i) \
        __builtin_amdgcn_global_load_lds((const unsigned*)((const char*)(gbase) + (voff)[_i]), (LAS unsigned*)(lds + (bufoff) + ldsw + _i * 8192), 16, 0, 0); } while (0)
#define PG8_LDA(dst, b, h) do { _Pragma("unroll") for (int m = 0; m < 4; ++m) _Pragma("unroll") for (int k = 0; k < 2; ++k) dst[m][k] = *(const LAS bf16x8*)(lds + PG8_SA(b, h) + aoff + m * 2048 + k * 1024); } while (0)
#define PG8_LDB(dst, b, h) do { _Pragma("unroll") for (int n = 0; n < 2; ++n) _Pragma("unroll") for (int k = 0; k < 2; ++k) dst[n][k] = *(const LAS bf16x8*)(lds + PG8_SB(b, h) + boff + n * 2048 + k * 1024); } while (0)
#define PG8_MMA(ai, bj, At, Bt) do { __builtin_amdgcn_s_setprio(1); _Pragma("unroll") for (int m = 0; m < 4; ++m) _Pragma("unroll") for (int n = 0; n < 2; ++n) _Pragma("unroll") for (int k = 0; k < 2; ++k) \
        acc[ai][bj][m][n] = __builtin_amdgcn_mfma_f32_16x16x32_bf16(Bt[n][k], At[m][k], acc[ai][bj][m][n], 0, 0, 0); __builtin_amdgcn_s_setprio(0); } while (0)
#define PG8_WAIT_V(n) asm volatile("s_waitcnt vmcnt(" #n ")" ::: "memory")
#define PG8_WAIT_L(n) asm volatile("s_waitcnt lgkmcnt(" #n ")" ::: "memory")
#define PG8_BAR __builtin_amdgcn_s_barrier()
#define PG8_SCHED __builtin_amdgcn_sched_barrier(0)
    Unit cur, nxt; int ui = 0;
    if (!S.next(0, cur)) return;
    f32x4 acc[2][2][4][2];
#pragma unroll
    for (int a = 0; a < 2; ++a)
#pragma unroll
        for (int b = 0; b < 2; ++b)
#pragma unroll
            for (int m = 0; m < 4; ++m)
#pragma unroll
                for (int n = 0; n < 2; ++n) acc[a][b][m][n] = (f32x4){0.f, 0.f, 0.f, 0.f};
    bf16x8 At[4][2], B0[2][2], B1[2][2];
    const char* cA = (const char*)g.A + cur.aoff; const char* cB = (const char*)g.Bt + cur.boff;
    PG8_STAGE(PG8_SB(0, 0), cB, voffB); PG8_STAGE(PG8_SB(0, 1), cB + hB, voffB); PG8_STAGE(PG8_SA(0, 0), cA, voffA); PG8_STAGE(PG8_SA(0, 1), cA + hA, voffA);
    if (wr == 1) PG8_BAR;
    PG8_WAIT_V(2); PG8_BAR;
    PG8_STAGE(PG8_SB(1, 0), cB + kstep, voffB); PG8_STAGE(PG8_SA(1, 0), cA + kstep, voffA); PG8_STAGE(PG8_SB(1, 1), cB + hB + kstep, voffB);
    PG8_WAIT_V(6); PG8_BAR;
    for (;;) {
        const bool has_next = S.next(ui + 1, nxt);
        const char* nA = has_next ? (const char*)g.A + nxt.aoff : cA; const char* nB = has_next ? (const char*)g.Bt + nxt.boff : cB;
        for (int t = 0; t < nt; t += 2) {
            const bool last = (t == nt - 2);
            const char* a1 = cA + (size_t)(t + 1) * kstep;
            const char* a2 = last ? nA : cA + (size_t)(t + 2) * kstep; const char* b2 = last ? nB : cB + (size_t)(t + 2) * kstep;
            const char* a3 = a2 + kstep; const char* b3 = b2 + kstep;
            PG8_LDB(B0, 0, 0); PG8_LDB(B1, 0, 1); PG8_SCHED; PG8_LDA(At, 0, 0); PG8_STAGE(PG8_SA(1, 1), a1 + hA, voffA);
            PG8_WAIT_V(8); PG8_WAIT_L(0); PG8_BAR; PG8_MMA(0, 0, At, B0); PG8_MMA(0, 1, At, B1); PG8_BAR; PG8_SCHED;
            PG8_LDA(At, 0, 1); PG8_STAGE(PG8_SB(0, 0), b2, voffB); PG8_STAGE(PG8_SB(0, 1), b2 + hB, voffB); PG8_STAGE(PG8_SA(0, 0), a2, voffA);
            PG8_WAIT_V(8); PG8_WAIT_L(0); PG8_BAR; PG8_MMA(1, 0, At, B0); PG8_MMA(1, 1, At, B1); PG8_BAR; PG8_SCHED;
            PG8_LDB(B0, 1, 0); PG8_LDB(B1, 1, 1); PG8_SCHED; PG8_LDA(At, 1, 0); PG8_STAGE(PG8_SA(0, 1), a2 + hA, voffA);
            PG8_WAIT_V(8); PG8_WAIT_L(0); PG8_BAR; PG8_MMA(0, 0, At, B0); PG8_MMA(0, 1, At, B1); PG8_BAR; PG8_SCHED;
            PG8_LDA(At, 1, 1); PG8_STAGE(PG8_SB(1, 0), b3, voffB); PG8_STAGE(PG8_SB(1, 1), b3 + hB, voffB); PG8_STAGE(PG8_SA(1, 0), a3, voffA);
            PG8_WAIT_V(8); PG8_WAIT_L(0); PG8_BAR; PG8_MMA(1, 0, At, B0); PG8_MMA(1, 1, At, B1); PG8_BAR; PG8_SCHED;
        }
        if (wr == 0) PG8_BAR;
        E(acc, cur, wr, wc, fr, fq);
        if (!has_next) break;
#pragma unroll
        for (int a = 0; a < 2; ++a)
#pragma unroll
            for (int b = 0; b < 2; ++b)
#pragma unroll
                for (int m = 0; m < 4; ++m)
#pragma unroll
                    for (int n = 0; n < 2; ++n) acc[a][b][m][n] = (f32x4){0.f, 0.f, 0.f, 0.f};
        cur = nxt; cA = nA; cB = nB; ++ui;
        if (wr == 1) PG8_BAR;
    }
    PG8_WAIT_V(0);
    PG8_BAR;
#undef PG8_SA
#undef PG8_SB
#undef PG8_STAGE
#undef PG8_LDA
#undef PG8_LDB
#undef PG8_MMA
#undef PG8_WAIT_V
#undef PG8_WAIT_L
#undef PG8_BAR
#undef PG8_SCHED
}
}
using pg8::Unit;
typedef f32x4 Acc[2][2][4][2];

struct EpiSwiglu {
    static constexpr bool PERM = true;
    bf16_t* O;
    __device__ __forceinline__ void operator()(const Acc& acc, const Unit& u, int wr, int wc, int fr, int fq) const {
        const int row0 = u.pm * 256 + wr * 64 + fr, col0 = u.pn * 128 + wc * 32 + 8 * fq;
#pragma unroll
        for (int ai = 0; ai < 2; ++ai)
#pragma unroll
            for (int m = 0; m < 4; ++m) {
                const f32x4 a0 = acc[ai][0][m][0], a1 = acc[ai][0][m][1], b0 = acc[ai][1][m][0], b1 = acc[ai][1][m][1];
                u32x4 w;
                w.x = cvt_pk_bf16(silu_f(a0[0]) * b0[0], silu_f(a0[1]) * b0[1]); w.y = cvt_pk_bf16(silu_f(a0[2]) * b0[2], silu_f(a0[3]) * b0[3]);
                w.z = cvt_pk_bf16(silu_f(a1[0]) * b1[0], silu_f(a1[1]) * b1[1]); w.w = cvt_pk_bf16(silu_f(a1[2]) * b1[2], silu_f(a1[3]) * b1[3]);
                *(u32x4*)(O + (size_t)(row0 + ai * 128 + m * 16) * DFF + col0) = w;
            }
    }
};

struct EpiResid {
    static constexpr bool PERM = false;
    const float* base_lat; const float* base_ctx; float* out; const float* gate; float wgt;
    __device__ __forceinline__ void operator()(const Acc& acc, const Unit& u, int wr, int wc, int fr, int fq) const {
        const int bb = u.pm < 256 ? (u.pm >> 5) : 8;
        const float* base = u.pm < 256 ? base_lat + (size_t)u.pm * 256 * D : base_ctx + (size_t)(u.pm - 256) * 256 * D;
        float* o = out + (size_t)u.pm * 256 * D;
        const int col0 = u.pn * 256 + wc * 32 + 4 * fq;
#pragma unroll
        for (int bj = 0; bj < 2; ++bj)
#pragma unroll
            for (int n = 0; n < 2; ++n) { const f32x4 gv = *(const f32x4*)(gate + (size_t)bb * 9 * D + col0 + bj * 128 + n * 16) * wgt;
#pragma unroll
                for (int ai = 0; ai < 2; ++ai) {
#pragma unroll
                    for (int m = 0; m < 4; ++m) { const size_t off = (size_t)(ai * 128 + wr * 64 + m * 16 + fr) * D + col0 + bj * 128 + n * 16;
                        const f32x4 bs = *(const f32x4*)(base + off); *(f32x4*)(o + off) = bs * ALPHA + gv * acc[ai][bj][m][n]; }
                    asm volatile("" ::: "memory"); } }
    }
};

struct EpiRope {
    static constexpr bool PERM = false;
    bf16_t* O; const float* cosT; const float* sinT;
    __device__ __forceinline__ void operator()(const Acc& acc, const Unit& u, int wr, int wc, int fr, int fq) const {
        const bool lat = u.pm < 256;
        const int col0 = u.pn * 256 + wc * 32 + 4 * fq;
        const bool rope_tile = (u.pn == 2 || u.pn == 3 || (u.pn == 4 && lat));
#pragma unroll
        for (int ai = 0; ai < 2; ++ai)
#pragma unroll
            for (int m = 0; m < 4; ++m) {
                const int row = u.pm * 256 + ai * 128 + wr * 64 + m * 16 + fr;
                const int t = row & (SEQ - 1), pos = (wc & 1) ? (t & 63) : (t >> 6);
                f32x4 cs = (f32x4){1.f, 1.f, 1.f, 1.f}, sn = (f32x4){0.f, 0.f, 0.f, 0.f};
                if (rope_tile) { cs = *(const f32x4*)(cosT + pos * 16 + 4 * fq); sn = *(const f32x4*)(sinT + pos * 16 + 4 * fq); }
#pragma unroll
                for (int bj = 0; bj < 2; ++bj) {
                    f32x4 t1 = acc[ai][bj][m][0], t2 = acc[ai][bj][m][1];
                    const bool rot = rope_tile && !(u.pn == 4 && bj == 1);
                    if (rot) { const f32x4 r1 = t1 * cs - t2 * sn, r2 = t1 * sn + t2 * cs; t1 = r1; t2 = r2; }
                    bf16_t* p = O + (size_t)row * INDIM + col0 + bj * 128;
                    u32x2 w1; w1.x = cvt_pk_bf16(t1[0], t1[1]); w1.y = cvt_pk_bf16(t1[2], t1[3]);
                    u32x2 w2; w2.x = cvt_pk_bf16(t2[0], t2[1]); w2.y = cvt_pk_bf16(t2[2], t2[3]);
                    *(u32x2*)p = w1; *(u32x2*)(p + 16) = w2;
                }
            }
    }
};

struct EpiPool {
    static constexpr bool PERM = true;
    bf16_t* O; const float* scale;
    __device__ __forceinline__ void operator()(const Acc& acc, const Unit& u, int wr, int wc, int fr, int fq) const {
        const int row0 = u.pm * 256 + wr * 64 + fr, col0 = u.pn * 256 + wc * 32 + 8 * fq;
#pragma unroll
        for (int bj = 0; bj < 2; ++bj) {
            const f32x4 s0 = *(const f32x4*)(scale + col0 + bj * 128), s1 = *(const f32x4*)(scale + col0 + bj * 128 + 4);
#pragma unroll
            for (int ai = 0; ai < 2; ++ai)
#pragma unroll
                for (int m = 0; m < 4; ++m) { const f32x4 v0 = acc[ai][bj][m][0] * s0, v1 = acc[ai][bj][m][1] * s1;
                    u32x4 w; w.x = cvt_pk_bf16(v0[0], v0[1]); w.y = cvt_pk_bf16(v0[2], v0[3]); w.z = cvt_pk_bf16(v1[0], v1[1]); w.w = cvt_pk_bf16(v1[2], v1[3]);
                    *(u32x4*)(O + (size_t)(row0 + ai * 128 + m * 16) * D + col0 + bj * 128) = w; }
        }
    }
};

struct F1Order { int G, c;
    __device__ bool next(int i, Unit& u) const { const int id = i * G + c; if (id >= 2048) return false; u.pm = id & 1; u.pn = id >> 1;
        const int j = u.pn & 31, g = (u.pn >> 5) & 3, b = u.pn >> 7; u.aoff = (size_t)u.pm * 256 * 256 * 2; u.boff = (((size_t)b * SEQ + 2 * j) * D + g * 256) * 2; return true; } };
struct EpiF1 {
    static constexpr bool PERM = false;
    bf16_t* Yt;
    __device__ __forceinline__ void operator()(const Acc& acc, const Unit& u, int wr, int wc, int fr, int fq) const {
        const int j = u.pn & 31, g = (u.pn >> 5) & 3, b = u.pn >> 7, ri = u.pm;
#pragma unroll
        for (int ai = 0; ai < 2; ++ai)
#pragma unroll
            for (int m = 0; m < 4; ++m) { const int cp = ai * 128 + wr * 64 + m * 16 + fr;
#pragma unroll
                for (int bj = 0; bj < 2; ++bj)
#pragma unroll
                    for (int n = 0; n < 2; ++n) { const int t2 = 2 * j + bj, t1 = 32 * wc + 16 * n + 4 * fq; const f32x4 v = acc[ai][bj][m][n];
                        u32x2 w; w.x = cvt_pk_bf16(v[0], v[1]); w.y = cvt_pk_bf16(v[2], v[3]);
                        *(u32x2*)(Yt + ((((size_t)(g * 256 + cp) * 8 + b) * 64 + t2) * 2 + ri) * 128 + t1) = w; } }
    }
};
struct FAOrder { int G, c;
    __device__ bool next(int i, Unit& u) const { const int id = i * G + c; if (id >= 2048) return false; u.pm = 0; u.pn = id; u.aoff = 0; u.boff = (size_t)id * 256 * 512; return true; } };
struct EpiFA {
    static constexpr bool PERM = false;
    bf16_t* Ut;
    __device__ __forceinline__ void operator()(const Acc& acc, const Unit& u, int wr, int wc, int fr, int fq) const {
        const int b4 = u.pn & 1, cp = (u.pn >> 1) & 255, g = u.pn >> 9;
#pragma unroll
        for (int m = 0; m < 4; ++m) { const int k1 = wr * 64 + m * 16 + fr;
#pragma unroll
            for (int n = 0; n < 2; ++n) { const int t2 = 32 * (wc & 1) + 16 * n + 4 * fq; f32x4 cs, sn; int kk = k1; asm volatile("" : "+v"(kk) :: "memory");
#pragma unroll
                for (int e = 0; e < 4; ++e) { const float rev = (float)(kk * (t2 + e)) * (1.0f / 8192.0f); cs[e] = __builtin_amdgcn_cosf(rev); sn[e] = __builtin_amdgcn_sinf(rev); }
#pragma unroll
                for (int bj = 0; bj < 2; ++bj) { const int b = 4 * b4 + 2 * bj + (wc >> 1); const f32x4 ur = acc[0][bj][m][n], ui = acc[1][bj][m][n];
                    const f32x4 orr = ur * cs + ui * sn, oi = ui * cs - ur * sn;
                    bf16_t* p = Ut + ((((((size_t)(g * 8 + b) * 32 + (kk >> 2)) * 256 + cp) * 4 + (kk & 3)) * 2) * 64) + t2;
                    u32x2 w; w.x = cvt_pk_bf16(orr[0], orr[1]); w.y = cvt_pk_bf16(orr[2], orr[3]); *(u32x2*)p = w;
                    w.x = cvt_pk_bf16(oi[0], oi[1]); w.y = cvt_pk_bf16(oi[2], oi[3]); *(u32x2*)(p + 64) = w; }
                asm volatile("" ::: "memory"); } }
    }
};
struct FCOrder { int G, c;
    __device__ bool next(int i, Unit& u) const { const int id = i * G + c; if (id >= 1024) return false; u.pm = 0; u.pn = id; u.aoff = 0; u.boff = (size_t)id * 256 * 1024; return true; } };
struct EpiFC {
    static constexpr bool PERM = false;
    bf16_t* F;
    __device__ __forceinline__ void operator()(const Acc& acc, const Unit& u, int wr, int wc, int fr, int fq) const {
        const int k1hi = u.pn & 31, b = (u.pn >> 5) & 7, g = u.pn >> 8;
#pragma unroll
        for (int ai = 0; ai < 2; ++ai)
#pragma unroll
            for (int m = 0; m < 4; ++m) { const int k1l = 2 * ai + wr, k2 = 16 * m + fr, tok = 4 * k1hi + k1l + 128 * k2;
#pragma unroll
                for (int bj = 0; bj < 2; ++bj)
#pragma unroll
                    for (int n = 0; n < 2; ++n) { const int cp = 128 * bj + 32 * wc + 16 * n + 4 * fq; const f32x4 v = acc[ai][bj][m][n];
                        u32x2 w; w.x = cvt_pk_bf16(v[0], v[1]); w.y = cvt_pk_bf16(v[2], v[3]);
                        *(u32x2*)(F + ((size_t)b * SEQ + tok) * D + g * 256 + cp) = w; } }
    }
};
struct Ctx {
    LAS unsigned char* lds; int tid, lane, wave, G, bid;
};
#define LDS_WAIT() asm volatile("s_waitcnt lgkmcnt(0)" ::: "memory")

__device__ __forceinline__ void transpose_item(const float* W, int K, int N, bf16_t* WT, int ldo, int k0, int n0, int orow0, LAS float* scr, int lane) {
#pragma unroll 8
    for (int i = 0; i < 32; ++i) { const int kk = 2 * i + (lane >> 5); scr[kk * 33 + (lane & 31)] = W[(size_t)(k0 + kk) * N + n0 + (lane & 31)]; }
    LDS_WAIT(); asm volatile("" ::: "memory");
    const int c = lane & 7;
#pragma unroll
    for (int j = 0; j < 4; ++j) { const int n = (lane >> 3) + 8 * j; const LAS float* s = scr + (8 * c) * 33 + n;
        u32x4 o; o.x = pk2(s[0 * 33], s[1 * 33]); o.y = pk2(s[2 * 33], s[3 * 33]); o.z = pk2(s[4 * 33], s[5 * 33]); o.w = pk2(s[6 * 33], s[7 * 33]);
        *(u32x4*)(WT + (size_t)(orow0 + n) * ldo + k0 + 8 * c) = o; }
    LDS_WAIT(); asm volatile("" ::: "memory");
}

struct In {
    const float *x, *c, *ctx, *c_ctx, *ada_w, *ada_b, *ln_g, *ln_b, *f1w1, *f1w3, *f1w2, *f2w1, *f2w3, *f2w2, *w_in, *pool_w, *pool_scale, *sinks, *w_out, *fw_out;
};

__device__ __forceinline__ void p0_mod(const Ctx& X, const In& I, float* MOD) {
    LAS float* S = (LAS float*)X.lds;
    LAS float* R = (LAS float*)(X.lds + 9 * 1024 * 4);
    if (X.bid >= 288) return;
    for (int i = X.tid; i < 9 * 1024; i += 512) { const float v = i < 8 * 1024 ? I.c[i] : I.c_ctx[i - 8 * 1024]; S[i] = v / (1.0f + __expf(-v)); }
    __syncthreads();
    for (int item = X.bid; item < 288; item += X.G) {
        const int l = item / 144, n = (item % 144) * 64 + (X.tid & 63), ks = X.tid >> 6;
        float a[9];
#pragma unroll
        for (int b = 0; b < 9; ++b) a[b] = 0.f;
        const float* w = I.ada_w + (size_t)l * D * 9 * D + n;
        for (int k = ks * 128; k < ks * 128 + 128; ++k) { const float wv = w[(size_t)k * 9 * D];
#pragma unroll
            for (int b = 0; b < 9; ++b) a[b] += S[b * 1024 + k] * wv; }
#pragma unroll
        for (int b = 0; b < 9; ++b) R[(ks * 9 + b) * 64 + (X.tid & 63)] = a[b];
        __syncthreads();
        for (int o = X.tid; o < 9 * 64; o += 512) { const int b = o >> 6, cc = o & 63; float s = 0.f;
#pragma unroll
            for (int k2 = 0; k2 < 8; ++k2) s += R[(k2 * 9 + b) * 64 + cc];
            const int nn = (item % 144) * 64 + cc; MOD[((size_t)l * 9 + b) * 9 * D + nn] = s + I.ada_b[(size_t)l * 9 * D + nn]; }
        __syncthreads();
    }
}
__device__ __forceinline__ void p0_weights(const Ctx& X, const In& I, const float* const* inp, unsigned char* ws) {
    LAS float* scr = (LAS float*)(X.lds + 65536 + X.wave * 8704);
    const int gw = X.bid * 8 + X.wave, NGW = X.G * 8;
    constexpr int I_UP = 16 * 88, I_DN = 44 * 32, I_IN = 16 * 40, I_SQ = 16 * 32;
    constexpr int NITEMS = 8 * I_UP + 4 * I_DN + I_IN + 2 * I_SQ;
    for (int it = gw; it < NITEMS; it += NGW) {
        int r = it;
        if (r < 8 * I_UP) { const int which = r / I_UP, q = r % I_UP, kb = q / 88, nb = q % 88, lf = which >> 1, w13 = which & 1;
            const float* src = inp[8 + 3 * (lf & 1) + w13] + (size_t)(lf >> 1) * D * DFF;
            const int n0 = nb * 32; transpose_item(src, D, DFF, (bf16_t*)(ws + WS_WUP + (size_t)lf * WUP_SZ), D, kb * 64, n0, (n0 >> 7) * 256 + w13 * 128 + (n0 & 127), scr, X.lane); continue; }
        r -= 8 * I_UP;
        if (r < 4 * I_DN) { const int lf = r / I_DN, q = r % I_DN, kb = q / 32, nb = q % 32;
            const float* src = inp[10 + 3 * (lf & 1)] + (size_t)(lf >> 1) * DFF * D;
            transpose_item(src, DFF, D, (bf16_t*)(ws + WS_WDN + (size_t)lf * WDN_SZ), DFF, kb * 64, nb * 32, nb * 32, scr, X.lane); continue; }
        r -= 4 * I_DN;
        if (r < I_IN) { const int kb = r / 40, nb = r % 40; transpose_item(I.w_in, D, INDIM, (bf16_t*)(ws + WS_WIN), D, kb * 64, nb * 32, nb * 32, scr, X.lane); continue; }
        r -= I_IN;
        if (r < I_SQ) { const int kb = r / 32, nb = r % 32; transpose_item(I.w_out, D, D, (bf16_t*)(ws + WS_WOUT), D, kb * 64, nb * 32, nb * 32, scr, X.lane); continue; }
        r -= I_SQ;
        { const int kb = r / 32, nb = r % 32; transpose_item(I.fw_out, D, D, (bf16_t*)(ws + WS_WF), D, kb * 64, nb * 32, nb * 32, scr, X.lane); }
    }
    const int gt = X.bid * 512 + X.tid, NGT = X.G * 512;
    bf16_t* Wp = (bf16_t*)(ws + WS_WPBD);
    for (int i = gt; i < 512 * 512; i += NGT) { const int n = i >> 9, k = i & 511; Wp[i] = ((n >> 7) == (k >> 7)) ? (bf16_t)f2bf(I.pool_w[((size_t)(n >> 7) * 128 + (k & 127)) * 128 + (n & 127)]) : (bf16_t)0; }
    bf16_t* Wch = (bf16_t*)(ws + WS_WCH);
    for (int i = gt; i < 512 * 256; i += NGT) { const int m = i >> 8, c = i & 255, cp = m & 255, ri = m >> 8; const float rev = (float)((c * cp) & 255) * (1.0f / 256.0f);
        const float v = ri ? -__builtin_amdgcn_sinf(rev) : __builtin_amdgcn_cosf(rev); Wch[i] = (bf16_t)f2bf(v * 0.0625f); }
    bf16_t* WA = (bf16_t*)(ws + WS_WA);
    for (int i = gt; i < 256 * 256; i += NGT) { const int m = i >> 8, kk = i & 255, ro = m >> 7, k1 = m & 127, ri = kk >> 7, t1 = kk & 127; const float rev = (float)((k1 * t1) & 127) * (1.0f / 128.0f);
        const float cs = __builtin_amdgcn_cosf(rev), sn = __builtin_amdgcn_sinf(rev); const float v = (ro == ri) ? cs : (ro == 0 ? sn : -sn); WA[i] = (bf16_t)f2bf(v * 0.08838834764f); }
    bf16_t* WC = (bf16_t*)(ws + WS_WC);
    for (int i = gt; i < 256 * 512; i += NGT) { const int m = i >> 9, kk = i & 511, k1l = m >> 6, k2 = m & 63, k1lp = kk >> 7, ri = (kk >> 6) & 1, t2 = kk & 63; const float rev = (float)((k2 * t2) & 63) * (1.0f / 64.0f);
        const float v = (k1l == k1lp) ? (ri ? __builtin_amdgcn_sinf(rev) : __builtin_amdgcn_cosf(rev)) * 0.125f : 0.f; WC[i] = (bf16_t)f2bf(v); }
    float* cosT = (float*)(ws + WS_ROPE); float* sinT = cosT + 2048;
    for (int i = gt; i < 2048; i += NGT) { const int pos = i >> 4, jj = i & 15; const float freq = __builtin_amdgcn_exp2f(-(float)jj * (13.2877123795f / 16.0f));
        const float ang = (float)pos * freq, rev = ang * 0.15915494309f, fr_ = rev - floorf(rev); cosT[i] = __builtin_amdgcn_cosf(fr_); sinT[i] = __builtin_amdgcn_sinf(fr_); }
}

template <bool AFF, bool MODU>
__device__ __forceinline__ void row_pass(const Ctx& X, int nrows, const float* zin_lat, const float* zin_ctx, float* xout, const float* lng, const float* lnb, const float* shv, const float* scv, bf16_t* H) {
    int lane_ = threadIdx.x & 63; asm volatile("" : "+v"(lane_)); const int lane = lane_;
    const int gw = X.bid * 8 + X.wave, NGW = X.G * 8;
    for (int row = gw; row < nrows; row += NGW) {
        const float* zr = row < MLAT ? zin_lat + (size_t)row * D : zin_ctx + (size_t)(row - MLAT) * D;
        f32x4 v[4]; float s = 0.f;
#pragma unroll
        for (int j = 0; j < 4; ++j) { v[j] = *(const f32x4*)(zr + 4 * lane + 256 * j); s += (v[j][0] + v[j][1]) + (v[j][2] + v[j][3]); }
        if (AFF) {
            const float mean = wave_sum(s) * (1.f / D); float s2 = 0.f;
#pragma unroll
            for (int j = 0; j < 4; ++j) { v[j] = v[j] - mean; s2 += (v[j][0] * v[j][0] + v[j][1] * v[j][1]) + (v[j][2] * v[j][2] + v[j][3] * v[j][3]); }
            const float rstd = 1.0f / sqrtf(wave_sum(s2) * (1.f / D) + LN_EPS);
            s = 0.f;
#pragma unroll
            for (int j = 0; j < 4; ++j) { const f32x4 gg = *(const f32x4*)(lng + 4 * lane + 256 * j), bb = *(const f32x4*)(lnb + 4 * lane + 256 * j);
                v[j] = v[j] * rstd * gg + bb; *(f32x4*)(xout + (size_t)row * D + 4 * lane + 256 * j) = v[j]; s += (v[j][0] + v[j][1]) + (v[j][2] + v[j][3]); }
        }
        if (MODU) {
            const int bb = row < MLAT ? (row >> 13) : 8;
            const float mean = wave_sum(s) * (1.f / D); float s2 = 0.f;
#pragma unroll
            for (int j = 0; j < 4; ++j) { v[j] = v[j] - mean; s2 += (v[j][0] * v[j][0] + v[j][1] * v[j][1]) + (v[j][2] * v[j][2] + v[j][3] * v[j][3]); }
            const float rstd = 1.0f / sqrtf(wave_sum(s2) * (1.f / D) + LN_EPS);
#pragma unroll
            for (int j = 0; j < 4; ++j) { const f32x4 sh = *(const f32x4*)(shv + (size_t)bb * 9 * D + 4 * lane + 256 * j), sc = *(const f32x4*)(scv + (size_t)bb * 9 * D + 4 * lane + 256 * j);
                const f32x4 o = v[j] * rstd * (sc + 1.0f) + sh; u32x2 w; w.x = pk2(o[0], o[1]); w.y = pk2(o[2], o[3]);
                *(u32x2*)(H + (size_t)row * D + 4 * lane + 256 * j) = w; }
        }
    }
}

__device__ __forceinline__ void pool_diff(const Ctx& X, const bf16_t* U, bf16_t* PD) {
    int tid_ = threadIdx.x; asm volatile("" : "+v"(tid_));
    const int gt = X.bid * 512 + tid_, NGT = X.G * 512;
    for (int item = gt; item < MLAT * 64; item += NGT) {
        const int row = item >> 6, c0 = (item & 63) * 8, g = c0 >> 7, hw = 1 << g, t = row & (SEQ - 1);
        const int lo = (t - hw) < 0 ? 0 : (t - hw), hi = (t + hw) > SEQ ? SEQ : (t + hw);
        float a[8];
#pragma unroll
        for (int e = 0; e < 8; ++e) a[e] = 0.f;
        const bf16_t* base = U + (size_t)(row - t) * INDIM + c0;
        for (int tt = lo; tt < hi; ++tt) { const u32x4 w = *(const u32x4*)(base + (size_t)tt * INDIM);
#pragma unroll
            for (int e = 0; e < 4; ++e) { a[2 * e] += bf2f(w[e]); a[2 * e + 1] += bf2f(w[e] >> 16); } }
        const float inv = 1.0f / (float)(hi - lo);
        const u32x4 sw = *(const u32x4*)(base + (size_t)t * INDIM); u32x4 o;
#pragma unroll
        for (int e = 0; e < 4; ++e) o[e] = pk2(a[2 * e] * inv - bf2f(sw[e]), a[2 * e + 1] * inv - bf2f(sw[e] >> 16));
        *(u32x4*)(PD + (size_t)row * 512 + c0) = o;
    }
}

__device__ __forceinline__ void attn_phase(const Ctx& X, const bf16_t* U, bf16_t* AO, const float* sinks) {
    int tid_ = threadIdx.x; asm volatile("" : "+v"(tid_));
    const int wid = X.wave, lane = tid_ & 63, fr = lane & 15, fq = lane >> 4;
    LAS bf16_t* Ks = (LAS bf16_t*)X.lds;
    LAS bf16_t* Vt = (LAS bf16_t*)(X.lds + 128 * 72 * 2);
    const float SC = 0.125f * LOG2E;
    for (int unit = X.bid; unit < 2048; unit += X.G) {
        const int half = unit & 1, blk = (unit >> 1) & 63, hkv = (unit >> 7) & 1, b = unit >> 8;
        const int hq = hkv * 4 + (wid >> 1), qi0 = half * 64 + (wid & 1) * 32;
        const size_t qrow0 = (size_t)b * SEQ + blk * 128 + qi0;
        float m_run[2], l_run[2]; f32x4 o[2][4];
        const float sk = sinks[hq] * LOG2E;
#pragma unroll
        for (int qg = 0; qg < 2; ++qg) { m_run[qg] = sk; l_run[qg] = 1.0f;
#pragma unroll
            for (int db = 0; db < 4; ++db) o[qg][db] = (f32x4){0.f, 0.f, 0.f, 0.f}; }
#pragma unroll 1
        for (int c = 0; c < 5; ++c) {
            if ((c == 0 && blk == 0) || (c == 2 && blk == 63)) continue;
            const size_t krow0 = c < 3 ? (size_t)b * SEQ + (size_t)(blk - 1 + c) * 128 : (size_t)MLAT + b * NCTX + (c - 3) * 128;
            __syncthreads();
#pragma unroll
            for (int i = 0; i < 2; ++i) { const int p = tid_ + 512 * i, key = p >> 3, dp = p & 7;
                const bf16_t* src = U + (krow0 + key) * INDIM + 1024 + hkv * 64 + 8 * dp;
                const u32x4 kv = *(const u32x4*)src, vv = *(const u32x4*)(src + 128);
                *(LAS u32x4*)(Ks + key * 72 + 8 * dp) = kv;
#pragma unroll
                for (int e = 0; e < 4; ++e) { Vt[(8 * dp + 2 * e) * 136 + key] = (bf16_t)(vv[e] & 0xffffu); Vt[(8 * dp + 2 * e + 1) * 136 + key] = (bf16_t)(vv[e] >> 16); } }
            __syncthreads();
            f32x4 s[2][8];
            bf16x8 qf[2][2];
#pragma unroll
            for (int qg = 0; qg < 2; ++qg)
#pragma unroll
                for (int ks = 0; ks < 2; ++ks) qf[qg][ks] = *(const bf16x8*)(U + (qrow0 + 16 * qg + fr) * INDIM + 512 + hq * 64 + 32 * ks + 8 * fq);
#pragma unroll
            for (int kb = 0; kb < 8; ++kb) {
                const bf16x8 k0 = *(const LAS bf16x8*)(Ks + (16 * kb + fr) * 72 + 8 * fq), k1 = *(const LAS bf16x8*)(Ks + (16 * kb + fr) * 72 + 32 + 8 * fq);
#pragma unroll
                for (int qg = 0; qg < 2; ++qg) { f32x4 z = (f32x4){0.f, 0.f, 0.f, 0.f};
                    z = __builtin_amdgcn_mfma_f32_16x16x32_bf16(k0, qf[qg][0], z, 0, 0, 0); s[qg][kb] = __builtin_amdgcn_mfma_f32_16x16x32_bf16(k1, qf[qg][1], z, 0, 0, 0); }
            }
#pragma unroll
            for (int qg = 0; qg < 2; ++qg) {
                const int q_idx = qi0 + 16 * qg + fr; float mx = -INFINITY;
#pragma unroll
                for (int kb = 0; kb < 8; ++kb)
#pragma unroll
                    for (int e = 0; e < 4; ++e) { const int k_idx = 16 * kb + 4 * fq + e; float v = s[qg][kb][e] * SC;
                        const bool valid = (c == 0) ? (k_idx >= q_idx) : ((c == 2) ? (k_idx <= q_idx) : true);
                        v = valid ? v : -INFINITY; s[qg][kb][e] = v; mx = fmaxf(mx, v); }
                mx = fmaxf(mx, __shfl_xor(mx, 16)); mx = fmaxf(mx, __shfl_xor(mx, 32));
                const float m_new = fmaxf(m_run[qg], mx), alpha = __builtin_amdgcn_exp2f(m_run[qg] - m_new); m_run[qg] = m_new;
                float rs = 0.f;
#pragma unroll
                for (int kb = 0; kb < 8; ++kb)
#pragma unroll
                    for (int e = 0; e < 4; ++e) { const float p = __builtin_amdgcn_exp2f(s[qg][kb][e] - m_new); s[qg][kb][e] = p; rs += p; }
                rs += __shfl_xor(rs, 16); rs += __shfl_xor(rs, 32);
                l_run[qg] = l_run[qg] * alpha + rs;
#pragma unroll
                for (int db = 0; db < 4; ++db) o[qg][db] = o[qg][db] * alpha;
            }
#pragma unroll
            for (int kg = 0; kg < 4; ++kg) {
                bf16x8 pf[2];
#pragma unroll
                for (int qg = 0; qg < 2; ++qg) { u32x4 w; w.x = cvt_pk_bf16(s[qg][2 * kg][0], s[qg][2 * kg][1]); w.y = cvt_pk_bf16(s[qg][2 * kg][2], s[qg][2 * kg][3]);
                    w.z = cvt_pk_bf16(s[qg][2 * kg + 1][0], s[qg][2 * kg + 1][1]); w.w = cvt_pk_bf16(s[qg][2 * kg + 1][2], s[qg][2 * kg + 1][3]); pf[qg] = __builtin_bit_cast(bf16x8, w); }
#pragma unroll
                for (int db = 0; db < 4; ++db) {
                    const LAS bf16_t* vp = Vt + (16 * db + fr) * 136 + 32 * kg + 4 * fq;
                    const u32x2 v0 = *(const LAS u32x2*)vp, v1 = *(const LAS u32x2*)(vp + 16);
                    u32x4 vw; vw.x = v0.x; vw.y = v0.y; vw.z = v1.x; vw.w = v1.y; const bf16x8 vf = __builtin_bit_cast(bf16x8, vw);
#pragma unroll
                    for (int qg = 0; qg < 2; ++qg) o[qg][db] = __builtin_amdgcn_mfma_f32_16x16x32_bf16(vf, pf[qg], o[qg][db], 0, 0, 0);
                }
            }
        }
#pragma unroll
        for (int qg = 0; qg < 2; ++qg) { const float inv = 1.0f / l_run[qg]; bf16_t* op = AO + (qrow0 + 16 * qg + fr) * D + 512 + hq * 64 + 4 * fq;
#pragma unroll
            for (int db = 0; db < 4; ++db) { const f32x4 v = o[qg][db] * inv; u32x2 w; w.x = cvt_pk_bf16(v[0], v[1]); w.y = cvt_pk_bf16(v[2], v[3]); *(u32x2*)(op + 16 * db) = w; } }
    }
}

#define XB_TMO      128
#define XB_XCNT(j)  (256  + 64 * (j))
#define XB_XSUB(j)  (1280 + 64 * (j))
#define XB_XGEN(j)  (2304 + 64 * (j))
#define XB_TOP      3328
#define XB_TOPGEN   3392
#define XCD_BAR_WORDS 3456
#define XB_SPIN_CAP (1u << 18)
__device__ __forceinline__ unsigned xb_ld(unsigned* p)              { return __hip_atomic_load(p, __ATOMIC_RELAXED, __HIP_MEMORY_SCOPE_AGENT); }
__device__ __forceinline__ unsigned xb_add(unsigned* p, unsigned v) { return __hip_atomic_fetch_add(p, v, __ATOMIC_RELAXED, __HIP_MEMORY_SCOPE_AGENT); }
__device__ __forceinline__ unsigned xb_xcc_id() { return (unsigned)__builtin_amdgcn_s_getreg((3 << 11) | 20) & 0xFu; }
#define XB_SPIN(cond, bar) do { unsigned _sp = 0; while (cond) { __builtin_amdgcn_s_sleep(1); \
    if ((++_sp & 255u) == 0u) { if (xb_ld(&(bar)[XB_TMO])) break; if (_sp > XB_SPIN_CAP) { atomicAdd(&(bar)[XB_TMO], 1u); break; } } } } while (0)
struct XcdBarrier { unsigned* bar; unsigned x; volatile LAS unsigned* st; };
__device__ __forceinline__ XcdBarrier xcd_barrier_post(unsigned* bar, volatile LAS unsigned* st) {
    XcdBarrier b; b.bar = bar; b.x = xb_xcc_id(); b.st = st;
    if (threadIdx.x == 0) (void)xb_add(&bar[XB_XCNT(b.x)], 1u);
    return b;
}
__device__ __forceinline__ void xcd_barrier_complete(unsigned* bar, unsigned x, unsigned& nloc, unsigned& nx) {
    const unsigned G = gridDim.x * gridDim.y * gridDim.z;
    unsigned sum, cnt, mine, sp = 0u;
    for (;;) {
        sum = 0u; cnt = 0u; mine = 0u;
#pragma unroll
        for (unsigned j = 0; j < 16; ++j) { const unsigned c = xb_ld(&bar[XB_XCNT(j)]); sum += c; cnt += (c > 0u) ? 1u : 0u; mine = (j == x) ? c : mine; }
        if (sum == G) break;
        __builtin_amdgcn_s_sleep(1);
        if ((++sp & 255u) == 0u) { if (xb_ld(&bar[XB_TMO])) break; if (sp > XB_SPIN_CAP) { atomicAdd(&bar[XB_TMO], 1u); break; } }
    }
    nloc = mine > 0u ? mine : 1u; nx = cnt > 0u ? cnt : 1u;
}
__device__ __forceinline__ void xcd_barrier(const XcdBarrier& b) {
    asm volatile("s_waitcnt vmcnt(0)" ::: "memory");
    __syncthreads();
    if (threadIdx.x == 0) {
        unsigned* bar = b.bar;
        __builtin_amdgcn_s_waitcnt(0);
        unsigned nloc = b.st[0], nx = b.st[1];
        if (nloc == 0u) { xcd_barrier_complete(bar, b.x, nloc, nx); b.st[0] = nloc; b.st[1] = nx; }
        const unsigned old = xb_add(&bar[XB_XSUB(b.x)], 1u);
        const unsigned gen = old / nloc;
        if (old + 1u == (gen + 1u) * nloc) {
            __builtin_amdgcn_fence(__ATOMIC_RELEASE, "agent");
            asm volatile("s_waitcnt vmcnt(0)" ::: "memory");
            const unsigned og = xb_add(&bar[XB_TOP], 1u);
            const unsigned tg = og / nx;
            if (og + 1u == (tg + 1u) * nx) xb_add(&bar[XB_TOPGEN], 1u);
            else XB_SPIN(xb_ld(&bar[XB_TOPGEN]) == tg, bar);
            __builtin_amdgcn_fence(__ATOMIC_ACQUIRE, "agent");
            xb_add(&bar[XB_XGEN(b.x)], 1u);
            asm volatile("s_waitcnt vmcnt(0)" ::: "memory");
        } else {
            XB_SPIN(xb_ld(&bar[XB_XGEN(b.x)]) == gen, bar);
            __builtin_amdgcn_fence(__ATOMIC_ACQUIRE, "agent");
            asm volatile("s_waitcnt vmcnt(0)" ::: "memory");
        }
    }
    __syncthreads();
}
struct Args { const float* in[20]; float* out; unsigned char* ws; };
__device__ __forceinline__ const float* ld_in(const Args& a, int i) { asm volatile("" : "+s"(i)); return a.in[i]; }
__device__ __forceinline__ unsigned char* ld_ws(const Args& a) { int z = 0; asm volatile("" : "+s"(z)); return (&a.ws)[z]; }
__device__ __forceinline__ float* ld_out(const Args& a) { int z = 0; asm volatile("" : "+s"(z)); return (&a.out)[z]; }
constexpr int LDS_BYTES = 147456;
#ifndef PROBE
#define PROBE 0
#endif
#define REP(k) _Pragma("unroll 1") for (int rep_ = 0; rep_ < ((PROBE == (k)) ? 2 : 1); ++rep_)

__global__ void __launch_bounds__(512, 2) fwd_kernel(Args args) {
    extern __shared__ __attribute__((aligned(16))) unsigned char lds_raw[];
    cg::grid_group grid = cg::this_grid();
    Ctx X; X.lds = (LAS unsigned char*)lds_raw; X.tid = threadIdx.x; X.lane = X.tid & 63; X.wave = __builtin_amdgcn_readfirstlane(X.tid >> 6); X.G = gridDim.x; X.bid = blockIdx.x;
#define INP(i) ld_in(args, (i))
#define WSP() ld_ws(args)
#define MOD ((float*)(WSP() + WS_MOD))
#define Z ((float*)(WSP() + WS_Z))
#define H ((bf16_t*)(WSP() + WS_H))
#define HID ((bf16_t*)(WSP() + WS_HID))
#define UIN ((bf16_t*)(WSP() + WS_UIN))
#define PD ((bf16_t*)(WSP() + WS_PD))
#define AO ((bf16_t*)(WSP() + WS_AO))
#define YT ((bf16_t*)(WSP() + WS_YT))
#define UT ((bf16_t*)(WSP() + WS_UT))
#define FB ((bf16_t*)(WSP() + WS_F))
#define MODP(l, chunk) (MOD + ((size_t)(l) * 81 + (chunk)) * D)
#define SYNC() do { xcd_barrier(bar); if (PROBE == 4) xcd_barrier(bar); } while (0)

    if (X.tid < 2) ((volatile LAS unsigned*)(X.lds + 147456 - 64))[X.tid] = 0u;
    __syncthreads();
    const XcdBarrier bar = xcd_barrier_post((unsigned*)(WSP() + WS_CTL + 16384), (volatile LAS unsigned*)(X.lds + 147456 - 64));
    REP(5) { In I; I.c = INP(1); I.c_ctx = INP(3); I.ada_w = INP(4); I.ada_b = INP(5); I.w_in = INP(14); I.pool_w = INP(15); I.w_out = INP(18); I.fw_out = INP(19);
      p0_mod(X, I, MOD); p0_weights(X, I, args.in, WSP()); }
    grid.sync();
    REP(5) row_pass<false, true>(X, MR, INP(0), INP(2), nullptr, nullptr, nullptr, MODP(0, 0), MODP(0, 1), H);
    SYNC();

#pragma unroll 1
    for (int s = 0; s < 4; ++s) {
        const int l = s >> 1, f = s & 1, Mrows = (s == 0) ? MR : MLAT;
        REP(2) { pg8::Gemm g{H, (const bf16_t*)(WSP() + WS_WUP + (size_t)s * WUP_SZ), D, 2048u, 2048u, (size_t)128 * 2048, (size_t)128 * 2048};
          pg8::StdOrder S; S.init(Mrows, NUP, X.G, X.bid, (size_t)256 * 2048, (size_t)256 * 2048);
          EpiSwiglu E{HID}; pg8::gemm_phase(X.lds, g, S, E); }
        SYNC();
        _Pragma("unroll 1") for (int rep_ = 0; rep_ < ((PROBE == 7 && s == 0) ? 2 : 1); ++rep_) { pg8::Gemm g{HID, (const bf16_t*)(WSP() + WS_WDN + (size_t)s * WDN_SZ), DFF, 5632u, 5632u, (size_t)128 * 5632, (size_t)128 * 5632};
          pg8::StdOrder S; S.init(Mrows, D, X.G, X.bid, (size_t)256 * 5632, (size_t)256 * 5632);
          EpiResid E{s == 0 ? INP(0) : Z, s == 0 ? INP(2) : Z + (size_t)MLAT * D, Z, MODP(l, f ? 8 : 2), 0.5f}; pg8::gemm_phase(X.lds, g, S, E); }
        SYNC();
        if (s == 3) { REP(8) row_pass<true, false>(X, MLAT, Z, Z, ld_out(args), INP(6) + (size_t)(l * 3 + 2) * D, INP(7) + (size_t)(l * 3 + 2) * D, nullptr, nullptr, nullptr); break; }
        { const int j = f ? 2 : 0; const int ml = (s == 1) ? 1 : l, mc = (s == 1) ? 0 : 3;
          row_pass<true, true>(X, Mrows, Z, Z + (size_t)MLAT * D, Z, INP(6) + (size_t)(l * 3 + j) * D, INP(7) + (size_t)(l * 3 + j) * D, MODP(ml, mc), MODP(ml, mc + 1), H); }
        SYNC();
        if (f == 1) continue;
        if (l == 0) {
            { pg8::Gemm g{H, (const bf16_t*)(WSP() + WS_WIN), D, 2048u, 2048u, (size_t)128 * 2048, (size_t)128 * 2048};
              pg8::StdOrder S; S.init(MR, INDIM, X.G, X.bid, (size_t)256 * 2048, (size_t)256 * 2048);
              EpiRope E{UIN, (const float*)(WSP() + WS_ROPE), (const float*)(WSP() + WS_ROPE) + 2048}; pg8::gemm_phase(X.lds, g, S, E); }
            SYNC();
            REP(1) { pool_diff(X, UIN, PD);
            attn_phase(X, UIN, AO, INP(17)); }
            SYNC();
            { pg8::Gemm g{PD, (const bf16_t*)(WSP() + WS_WPBD), 512, 1024u, 1024u, (size_t)128 * 1024, (size_t)128 * 1024};
              pg8::StdOrder S; S.init(MLAT, 512, X.G, X.bid, (size_t)256 * 1024, (size_t)256 * 1024);
              EpiPool E{AO, INP(16)}; pg8::gemm_phase(X.lds, g, S, E); }
            SYNC();
            { pg8::Gemm g{AO, (const bf16_t*)(WSP() + WS_WOUT), D, 2048u, 2048u, (size_t)128 * 2048, (size_t)128 * 2048};
              pg8::StdOrder S; S.init(MLAT, D, X.G, X.bid, (size_t)256 * 2048, (size_t)256 * 2048);
              EpiResid E{Z, Z, Z, MODP(0, 5), 1.0f}; pg8::gemm_phase(X.lds, g, S, E); }
        } else {
            REP(6) { pg8::Gemm g{(const bf16_t*)(WSP() + WS_WCH), H, 256, 512u, 131072u, (size_t)128 * 512, (size_t)2048};
              F1Order S{X.G, X.bid}; EpiF1 E{YT}; pg8::gemm_phase(X.lds, g, S, E); }
            SYNC();
            REP(6) { pg8::Gemm g{(const bf16_t*)(WSP() + WS_WA), YT, 256, 512u, 512u, (size_t)128 * 512, (size_t)128 * 512};
              FAOrder S{X.G, X.bid}; EpiFA E{UT}; pg8::gemm_phase(X.lds, g, S, E); }
            SYNC();
            REP(6) { pg8::Gemm g{(const bf16_t*)(WSP() + WS_WC), UT, 512, 1024u, 1024u, (size_t)128 * 1024, (size_t)128 * 1024};
              FCOrder S{X.G, X.bid}; EpiFC E{FB}; pg8::gemm_phase(X.lds, g, S, E); }
            SYNC();
            { pg8::Gemm g{FB, (const bf16_t*)(WSP() + WS_WF), D, 2048u, 2048u, (size_t)128 * 2048, (size_t)128 * 2048};
              pg8::StdOrder S; S.init(MLAT, D, X.G, X.bid, (size_t)256 * 2048, (size_t)256 * 2048);
              EpiResid E{Z, Z, Z, MODP(1, 5), 1.0f}; pg8::gemm_phase(X.lds, g, S, E); }
        }
        SYNC();
        row_pass<true, true>(X, MLAT, Z, Z, Z, INP(6) + (size_t)(l * 3 + 1) * D, INP(7) + (size_t)(l * 3 + 1) * D, MODP(l, 6), MODP(l, 7), H);
        SYNC();
    }
}

extern "C" void kernel_launch(void* const* d_in, const int* in_sizes, int n_in, void* d_out, int out_size, void* d_ws, size_t ws_size, hipStream_t stream) {
    static int grid = 0;
    if (grid == 0) {
        if (n_in != 20 || out_size != MLAT * D || ws_size < WS_END) { fprintf(stderr, "kernel_launch: unexpected problem: n_in %d out %d ws %zu (need %zu)\n", n_in, out_size, ws_size, (size_t)WS_END); grid = -1; return; }
        int dev = 0, cus = 0, per_cu = 0;
        (void)hipGetDevice(&dev); (void)hipDeviceGetAttribute(&cus, hipDeviceAttributeMultiprocessorCount, dev);
        (void)hipFuncSetAttribute((const void*)fwd_kernel, hipFuncAttributeMaxDynamicSharedMemorySize, LDS_BYTES);
        (void)hipOccupancyMaxActiveBlocksPerMultiprocessor(&per_cu, (const void*)fwd_kernel, 512, LDS_BYTES);
        if (per_cu < 1) per_cu = 1;
        grid = cus * per_cu;
        fprintf(stderr, "kernel_launch: %d CUs x %d = grid %d\n", cus, per_cu, grid);
    }
    if (grid < 0) return;
    if (hipMemsetAsync((char*)d_ws + WS_CTL, 0, 1 << 20, stream) != hipSuccess) { fprintf(stderr, "kernel_launch: memset failed\n"); return; }
    Args a{};
    for (int i = 0; i < 20; ++i) a.in[i] = (const float*)d_in[i];
    a.out = (float*)d_out; a.ws = (unsigned char*)d_ws;
    void* kargs[] = {&a};
    hipError_t e = hipLaunchCooperativeKernel((const void*)fwd_kernel, dim3(grid), dim3(512), kargs, LDS_BYTES, stream);
    if (e != hipSuccess) fprintf(stderr, "kernel_launch: cooperative launch failed: %s (grid %d)\n", hipGetErrorString(e), grid);
}
```
